# Optimizing an MI355X kernel written in HIP

```python
import math
import jax, jax.numpy as jnp
from jax import lax
import numpy as np

D_MODEL = 1024
BATCH = 32
SEQ = 2048
DEPTH = 4

HEAD_DIM = 64
D_MIX = D_MODEL
N_GROUPS = 4
GROUP_WIDTH = D_MIX // N_GROUPS
HEADS_PER_GROUP = GROUP_WIDTH // HEAD_DIM
Q_BLOCK = 128
D_FF = 4 * D_MODEL
EPS = 1e-6
NEG_INF = -1e30

SB_HEADS = HEADS_PER_GROUP
NSA_HEADS = HEADS_PER_GROUP
NSA_KV_DIM = HEAD_DIM
CMP_LEN = 32
CMP_STRIDE = 16
CMP_HIDDEN = 2 * HEAD_DIM
SEL_LEN = 64
SEL_TOPN = 8
SEL_Q_BLOCK = 64
FORCE_SCORE = 1e9
NSA_WINDOW = 512
N_NSA_BRANCHES = 3
DIFF_HEADS = HEADS_PER_GROUP
DIFF_QK_DIM = HEAD_DIM // 2
DIFF_V_DIM = HEAD_DIM
SWA_HEADS = HEADS_PER_GROUP
SWA_KV_HEADS = 2
SWA_WINDOW = 128
N_ALIBI_HEADS = NSA_HEADS + DIFF_HEADS + SWA_HEADS

IN_SIZES = (
    SB_HEADS * HEAD_DIM, SB_HEADS * HEAD_DIM, SB_HEADS * HEAD_DIM,
    NSA_HEADS * HEAD_DIM, NSA_KV_DIM, NSA_KV_DIM, NSA_KV_DIM, NSA_KV_DIM, NSA_KV_DIM, NSA_KV_DIM,
    N_NSA_BRANCHES * NSA_HEADS,
    DIFF_HEADS * 2 * DIFF_QK_DIM, DIFF_HEADS * 2 * DIFF_QK_DIM, DIFF_HEADS * DIFF_V_DIM,
    SWA_HEADS * HEAD_DIM, SWA_KV_HEADS * HEAD_DIM, SWA_KV_HEADS * HEAD_DIM,
)
IN_COLS = sum(IN_SIZES)

kernel_name = "hybrid_parallel_heads_sb_nsa_diff_swa"


def _rmsnorm(x, gain=None):
    xf = x.astype(jnp.float32)
    y = xf * lax.rsqrt(jnp.mean(xf * xf, axis=-1, keepdims=True) + EPS)
    if gain is not None:
        y = y * gain.astype(jnp.float32)
    return y.astype(x.dtype)


def _alibi_slopes():
    m = 2.0 ** (-8.0 * np.arange(1, N_ALIBI_HEADS + 1) / N_ALIBI_HEADS)
    m = m.astype(np.float32).reshape(HEADS_PER_GROUP, 3)
    return jnp.asarray(m[:, 0]), jnp.asarray(m[:, 1]), jnp.asarray(m[:, 2])


def _sweep(block_fn, n_blocks):
    out = lax.map(block_fn, jnp.arange(n_blocks))
    nb, b, qb = out.shape[:3]
    return jnp.moveaxis(out, 0, 1).reshape((b, nb * qb) + out.shape[3:])


def _stick_breaking(q, k, v):
    B, S, H, d = q.shape
    scale = d ** -0.5
    kpos = jnp.arange(S)

    def block(i):
        start = i * Q_BLOCK
        qb = lax.dynamic_slice_in_dim(q, start, Q_BLOCK, axis=1)
        qpos = start + jnp.arange(Q_BLOCK)
        past = kpos[None, :] < qpos[:, None]
        z = jnp.einsum('bqhd,bkhd->bhqk', qb, k).astype(jnp.float32) * scale
        log_beta = jax.nn.log_sigmoid(z)
        log_keep = jnp.where(past, jax.nn.log_sigmoid(-z), 0.0)
        acc = lax.cumsum(log_keep, axis=3, reverse=True) - log_keep
        a = jnp.where(past, jnp.exp(log_beta + acc), 0.0)
        return jnp.einsum('bhqk,bkhd->bqhd', a.astype(v.dtype), v)

    return _sweep(block, S // Q_BLOCK)


def _banded_attention(q, k, v, slopes, window, sinks=None):
    B, S, H, d = q.shape
    kvh = k.shape[2]
    grp = H // kvh
    n_prev = -(-window // Q_BLOCK)
    pad = n_prev * Q_BLOCK
    band = pad + Q_BLOCK
    kp = jnp.pad(k, ((0, 0), (pad, 0), (0, 0), (0, 0)))
    vp = jnp.pad(v, ((0, 0), (pad, 0), (0, 0), (0, 0)))
    scale = d ** -0.5
    sl = slopes.reshape(kvh, grp)[None, :, :, None, None]

    def block(i):
        start = i * Q_BLOCK
        qb = lax.dynamic_slice_in_dim(q, start, Q_BLOCK, axis=1).reshape(B, Q_BLOCK, kvh, grp, d)
        kb = lax.dynamic_slice_in_dim(kp, start, band, axis=1)
        vb = lax.dynamic_slice_in_dim(vp, start, band, axis=1)
        qpos = start + jnp.arange(Q_BLOCK)
        kpos = start - pad + jnp.arange(band)
        dist = qpos[:, None] - kpos[None, :]
        mask = (dist >= 0) & (dist < window) & (kpos >= 0)[None, :]
        z = jnp.einsum('bqgrd,bkgd->bgrqk', qb, kb).astype(jnp.float32) * scale
        z = z - sl * dist.astype(jnp.float32)
        z = jnp.where(mask, z, NEG_INF)
        if sinks is not None:
            sk = jnp.broadcast_to(sinks.astype(jnp.float32).reshape(kvh, grp)[None, :, :, None, None],
                                  z.shape[:-1] + (1,))
            p = jax.nn.softmax(jnp.concatenate([z, sk], axis=-1), axis=-1)[..., :-1]
        else:
            p = jax.nn.softmax(z, axis=-1)
        o = jnp.einsum('bgrqk,bkgd->bqgrd', p.astype(vb.dtype), vb)
        return o.reshape(B, Q_BLOCK, H, d)

    return _sweep(block, S // Q_BLOCK)


def _native_sparse_attention(q, k_cmp, v_cmp, k_sel, v_sel, k_win, v_win, gate_logits,
                             pe_k, w1_k, w2_k, pe_v, w1_v, w2_v, slopes):
    B, S, H, d = q.shape
    scale = d ** -0.5
    tpos = jnp.arange(S)

    n_cmp = (S - CMP_LEN) // CMP_STRIDE + 1
    starts = CMP_STRIDE * np.arange(n_cmp)
    idx = starts[:, None] + np.arange(CMP_LEN)[None, :]

    def compress(t, pe, w1, w2):
        blk = (t[:, idx] + pe).reshape(B, n_cmp, CMP_LEN * t.shape[-1])
        return jax.nn.gelu(blk @ w1) @ w2

    kc = compress(k_cmp, pe_k, w1_k, w2_k)
    vc = compress(v_cmp, pe_v, w1_v, w2_v)
    dist_c = (tpos[:, None] - jnp.asarray(starts + CMP_LEN - 1)[None, :]).astype(jnp.float32)
    valid_c = dist_c >= 0
    z = jnp.einsum('bthd,bid->bhti', q, kc).astype(jnp.float32) * scale - slopes[:, None, None] * dist_c
    z = jnp.where(valid_c, z, NEG_INF)
    p_c = jax.nn.softmax(z, axis=-1) * valid_c
    o_cmp = jnp.einsum('bhti,bid->bthd', p_c.astype(vc.dtype), vc)

    n_sel = S // SEL_LEN
    n_top = min(SEL_TOPN, n_sel)
    to_sel = jax.nn.one_hot(starts // SEL_LEN, n_sel, dtype=jnp.float32)
    imp = jnp.einsum('bhti,ij->btj', p_c, to_sel)
    blk_id = jnp.arange(n_sel)[None, :]
    cur = (tpos // SEL_LEN)[:, None]
    forced = (blk_id == 0) | (blk_id == cur) | (blk_id == cur - 1)
    score = jnp.where(blk_id > cur, NEG_INF, jnp.where(forced, FORCE_SCORE, imp))
    _, sel = lax.top_k(score, n_top)
    ks_blk = k_sel.reshape(B, n_sel, SEL_LEN, d)
    vs_blk = v_sel.reshape(B, n_sel, SEL_LEN, d)
    sl5 = slopes[None, :, None, None, None]

    def sel_block(i):
        start = i * SEL_Q_BLOCK
        qb = lax.dynamic_slice_in_dim(q, start, SEL_Q_BLOCK, axis=1)
        sb = lax.dynamic_slice_in_dim(sel, start, SEL_Q_BLOCK, axis=1)
        kg = jax.vmap(lambda blk, s: blk[s])(ks_blk, sb)
        vg = jax.vmap(lambda blk, s: blk[s])(vs_blk, sb)
        qpos = start + jnp.arange(SEL_Q_BLOCK)
        kpos = sb[..., None] * SEL_LEN + jnp.arange(SEL_LEN)
        dist = (qpos[None, :, None, None] - kpos).astype(jnp.float32)[:, None]
        zs = jnp.einsum('bqhd,bqnld->bhqnl', qb, kg).astype(jnp.float32) * scale - sl5 * dist
        zs = jnp.where(dist >= 0, zs, NEG_INF)
        p = jax.nn.softmax(zs.reshape(B, H, SEL_Q_BLOCK, -1), axis=-1).reshape(zs.shape)
        return jnp.einsum('bhqnl,bqnld->bqhd', p.astype(vg.dtype), vg)

    o_sel = _sweep(sel_block, S // SEL_Q_BLOCK)

    o_win = _banded_attention(q, k_win[:, :, None], v_win[:, :, None], slopes, NSA_WINDOW)

    g = jax.nn.sigmoid(gate_logits.astype(jnp.float32))
    return (g[..., 0:1] * o_cmp + g[..., 1:2] * o_sel + g[..., 2:3] * o_win).astype(q.dtype)


def _differential_attention(q, k, v, slopes, lam):
    B, S, H, _, dqk = q.shape
    scale = dqk ** -0.5
    kpos = jnp.arange(S)
    sl = slopes[None, :, None, None, None]

    def block(i):
        start = i * Q_BLOCK
        qb = lax.dynamic_slice_in_dim(q, start, Q_BLOCK, axis=1)
        qpos = start + jnp.arange(Q_BLOCK)
        dist = (qpos[:, None] - kpos[None, :]).astype(jnp.float32)
        z = jnp.einsum('bqhcd,bkhcd->bhcqk', qb, k).astype(jnp.float32) * scale - sl * dist
        z = jnp.where(dist >= 0, z, NEG_INF)
        p = jax.nn.softmax(z, axis=-1)
        w = p[:, :, 0] - lam * p[:, :, 1]
        return jnp.einsum('bhqk,bkhd->bqhd', w.astype(v.dtype), v)

    return _sweep(block, S // Q_BLOCK)


def setup_inputs(seed: int = 0) -> dict:
    key = jax.random.key(seed)
    ks = jax.random.split(key, 24)
    f32 = jnp.float32

    def nrm(k, shape, scale):
        return jax.random.normal(k, shape, f32) * scale

    def gain(k, shape):
        return 1.0 + 0.01 * jax.random.normal(k, shape, f32)

    flat = CMP_LEN * NSA_KV_DIM
    return {
        "x": nrm(ks[0], (BATCH, SEQ, D_MODEL), 1.0),
        "norm_attn": gain(ks[1], (DEPTH, D_MODEL)),
        "w_in": nrm(ks[2], (DEPTH, D_MODEL, IN_COLS), D_MODEL ** -0.5),
        "cmp_pe_k": nrm(ks[3], (DEPTH, CMP_LEN, NSA_KV_DIM), 0.1),
        "cmp_w1_k": nrm(ks[4], (DEPTH, flat, CMP_HIDDEN), flat ** -0.5),
        "cmp_w2_k": nrm(ks[5], (DEPTH, CMP_HIDDEN, NSA_KV_DIM), CMP_HIDDEN ** -0.5),
        "cmp_pe_v": nrm(ks[6], (DEPTH, CMP_LEN, NSA_KV_DIM), 0.1),
        "cmp_w1_v": nrm(ks[7], (DEPTH, flat, CMP_HIDDEN), flat ** -0.5),
        "cmp_w2_v": nrm(ks[8], (DEPTH, CMP_HIDDEN, NSA_KV_DIM), CMP_HIDDEN ** -0.5),
        "diff_lq1": nrm(ks[9], (DEPTH, DIFF_QK_DIM), 0.1),
        "diff_lk1": nrm(ks[10], (DEPTH, DIFF_QK_DIM), 0.1),
        "diff_lq2": nrm(ks[11], (DEPTH, DIFF_QK_DIM), 0.1),
        "diff_lk2": nrm(ks[12], (DEPTH, DIFF_QK_DIM), 0.1),
        "sinks": nrm(ks[13], (DEPTH, SWA_HEADS), 0.5),
        "g_mix": gain(ks[14], (DEPTH, D_MIX)),
        "w_out": nrm(ks[15], (DEPTH, D_MIX, D_MODEL), D_MIX ** -0.5),
        "norm_mlp": gain(ks[16], (DEPTH, D_MODEL)),
        "w_up": nrm(ks[17], (DEPTH, D_MODEL, D_FF), D_MODEL ** -0.5),
        "w_down": nrm(ks[18], (DEPTH, D_FF, D_MODEL), 0.5 * D_FF ** -0.5),
        "norm_final": gain(ks[19], (D_MODEL,)),
    }


def reference(x, norm_attn, w_in, cmp_pe_k, cmp_w1_k, cmp_w2_k, cmp_pe_v, cmp_w1_v, cmp_w2_v,
              diff_lq1, diff_lk1, diff_lq2, diff_lk2, sinks, g_mix, w_out, norm_mlp, w_up, w_down,
              norm_final):
    B, S, _ = x.shape
    slopes_nsa, slopes_diff, slopes_swa = _alibi_slopes()
    split_at = [int(c) for c in np.cumsum(IN_SIZES)[:-1]]

    def heads(t, n):
        return t.reshape(B, S, n, -1)

    for l in range(DEPTH):
        h = _rmsnorm(x, norm_attn[l])
        proj = jnp.einsum('bsd,dc->bsc', h, w_in[l])
        (qa, ka, va, qn, kcn, vcn, ksn, vsn, kwn, vwn, gn,
         qc, kc, vc, qd, kd, vd) = jnp.split(proj, split_at, axis=-1)

        o_sb = _stick_breaking(heads(qa, SB_HEADS), heads(ka, SB_HEADS), heads(va, SB_HEADS))

        o_nsa = _native_sparse_attention(
            heads(qn, NSA_HEADS), kcn, vcn, ksn, vsn, kwn, vwn, heads(gn, NSA_HEADS),
            cmp_pe_k[l], cmp_w1_k[l], cmp_w2_k[l], cmp_pe_v[l], cmp_w1_v[l], cmp_w2_v[l], slopes_nsa)

        lam_init = 0.8 - 0.6 * math.exp(-0.3 * l)
        lam = (jnp.exp(jnp.sum(diff_lq1[l].astype(jnp.float32) * diff_lk1[l].astype(jnp.float32)))
               - jnp.exp(jnp.sum(diff_lq2[l].astype(jnp.float32) * diff_lk2[l].astype(jnp.float32)))
               + lam_init)
        o_diff = _differential_attention(qc.reshape(B, S, DIFF_HEADS, 2, DIFF_QK_DIM),
                                         kc.reshape(B, S, DIFF_HEADS, 2, DIFF_QK_DIM),
                                         heads(vc, DIFF_HEADS), slopes_diff, lam)
        o_diff = _rmsnorm(o_diff) * (1.0 - lam_init)

        o_swa = _banded_attention(heads(qd, SWA_HEADS), heads(kd, SWA_KV_HEADS), heads(vd, SWA_KV_HEADS),
                                  slopes_swa, SWA_WINDOW, sinks[l])

        mix = jnp.concatenate([_rmsnorm(o_sb.reshape(B, S, -1)),
                               _rmsnorm(o_nsa.reshape(B, S, -1)),
                               o_diff.reshape(B, S, -1),
                               _rmsnorm(o_swa.reshape(B, S, -1))], axis=-1)
        x = x + jnp.einsum('bsc,cd->bsd', mix * g_mix[l], w_out[l]).astype(x.dtype)

        h = _rmsnorm(x, norm_mlp[l])
        u = jax.nn.relu(jnp.einsum('bsd,df->bsf', h, w_up[l]))
        x = x + jnp.einsum('bsf,fd->bsd', u * u, w_down[l]).astype(x.dtype)

    return _rmsnorm(x, norm_final)
```

```cpp
#include <hip/hip_runtime.h>
#include <hip/hip_cooperative_groups.h>
#include <cstdio>
namespace cg = cooperative_groups;

typedef unsigned short bf16_t;
typedef short bf16x8 __attribute__((ext_vector_type(8)));
typedef short s16x4 __attribute__((ext_vector_type(4)));
typedef float f32x16 __attribute__((ext_vector_type(16)));
typedef float f32x4 __attribute__((ext_vector_type(4)));
typedef float f32x2 __attribute__((ext_vector_type(2)));
typedef unsigned u32x4 __attribute__((ext_vector_type(4)));
typedef unsigned u32x2 __attribute__((ext_vector_type(2)));
typedef __bf16 bf2_t __attribute__((ext_vector_type(2)));
#define DI __device__ __forceinline__
#define MFMA(a, b, c) __builtin_amdgcn_mfma_f32_32x32x16_bf16((a), (b), (c), 0, 0, 0)

constexpr int NTOK = 65536, SEQ = 2048, NB = 32, DM = 1024, DFF = 4096, NL = 4;
constexpr int NPROJ = 2816, QKW = 1920, VROWS = 768, INC = 2700;
constexpr float EPS = 1e-6f, LOG2E = 1.4426950408889634f;

constexpr size_t SZ_WIN = (size_t)NL * NPROJ * DM * 2, SZ_WOUT = (size_t)NL * DM * DM * 2, SZ_WUP = (size_t)NL * DFF * DM * 2, SZ_WDN = SZ_WUP;
constexpr size_t SZ_W1T = (size_t)NL * 2 * 128 * 2048 * 2, SZ_W2T = (size_t)NL * 2 * 64 * 128 * 2, SZ_C1 = 8 * 32 * 128 * 4;
constexpr size_t OFF_WIN = 0, OFF_WOUT = OFF_WIN + SZ_WIN, OFF_WUP = OFF_WOUT + SZ_WOUT, OFF_WDN = OFF_WUP + SZ_WUP;
constexpr size_t OFF_W1T = OFF_WDN + SZ_WDN, OFF_W2T = OFF_W1T + SZ_W1T, OFF_C1 = OFF_W2T + SZ_W2T;
constexpr size_t OFF_SSA = OFF_C1 + SZ_C1, OFF_SSB = OFF_SSA + NTOK * 32, OFF_CTR = OFF_SSB + NTOK * 32;
constexpr size_t OFF_XB = OFF_CTR + 4096, OFF_R = OFF_XB + (size_t)NTOK * DM * 2;
constexpr size_t OFF_QK = OFF_R, OFF_VT = OFF_QK + (size_t)NTOK * QKW * 2, OFF_GATE = OFF_VT + (size_t)NB * VROWS * SEQ * 2;
constexpr size_t OFF_KCMP = OFF_GATE + (size_t)NTOK * 16 * 4, OFF_VCMP = OFF_KCMP + (size_t)NB * 128 * 64 * 2, OFF_MIX = OFF_VCMP + (size_t)NB * 64 * 128 * 2;
constexpr size_t OFF_U = OFF_R;

struct Params {
  const float *x, *norm_attn, *w_in, *pe_k, *w1_k, *w2_k, *pe_v, *w1_v, *w2_v, *lq1, *lk1, *lq2, *lk2, *sinks, *g_mix, *w_out, *norm_mlp, *w_up, *w_down, *norm_final;
  float* xw;
  char* ws;
  int ph_lo, ph_hi;
};

DI int my_tid() { int t = threadIdx.x; asm volatile("" : "+v"(t)); return t; }
DI float row_rstd(const float* ss, int tok) {
  const float4 a = *(const float4*)(ss + (size_t)tok * 8), b = *(const float4*)(ss + (size_t)tok * 8 + 4);
  const float t = ((a.x + a.y) + (a.z + a.w)) + ((b.x + b.y) + (b.z + b.w));
  return rsqrtf(t * (1.f / 1024.f) + 1e-6f);
}
DI unsigned pk2(float a, float b) { f32x2 v = {a, b}; bf2_t r = __builtin_convertvector(v, bf2_t); return __builtin_bit_cast(unsigned, r); }
DI f32x4 unpk4(u32x2 u) { f32x4 r = {__uint_as_float(u[0] << 16), __uint_as_float(u[0] & 0xffff0000u), __uint_as_float(u[1] << 16), __uint_as_float(u[1] & 0xffff0000u)}; return r; }
DI bf16_t f2bf(float a) { return (bf16_t)(pk2(a, 0.f) & 0xffffu); }
DI float ex2(float x) { return __builtin_amdgcn_exp2f(x); }
DI bf16x8 cat8(s16x4 lo, s16x4 hi) { return __builtin_shufflevector(lo, hi, 0, 1, 2, 3, 4, 5, 6, 7); }
DI f32x16 zero16() { f32x16 z; _Pragma("unroll") for (int i = 0; i < 16; ++i) z[i] = 0.f; return z; }
DI bf16x8 pack8(float a0, float a1, float a2, float a3, float a4, float a5, float a6, float a7) {
  u32x4 u = {pk2(a0, a1), pk2(a2, a3), pk2(a4, a5), pk2(a6, a7)};
  return __builtin_bit_cast(bf16x8, u);
}

DI void cvt_tile(const float* __restrict__ src, int C, int c0, int valid, bf16_t* __restrict__ dst, int R, int r0, const float* __restrict__ gain, char* smem) {
  float* t = (float*)smem;
  const int tid = my_tid();
  {
    const int col = tid & 63;
    float v[8], g[8];
#pragma unroll
    for (int i = 0; i < 8; ++i) {
      const int row = i * 8 + (tid >> 6);
      v[i] = (col < valid) ? src[(size_t)(r0 + row) * C + c0 + col] : 0.f;
      g[i] = gain ? gain[r0 + row] : 1.f;
    }
#pragma unroll
    for (int i = 0; i < 8; ++i) t[(i * 8 + (tid >> 6)) * 65 + col] = v[i] * g[i];
  }
  __syncthreads();
  {
    const int j = tid >> 3, i8 = (tid & 7) * 8;
    u32x4 o;
    o[0] = pk2(t[(i8 + 0) * 65 + j], t[(i8 + 1) * 65 + j]); o[1] = pk2(t[(i8 + 2) * 65 + j], t[(i8 + 3) * 65 + j]);
    o[2] = pk2(t[(i8 + 4) * 65 + j], t[(i8 + 5) * 65 + j]); o[3] = pk2(t[(i8 + 6) * 65 + j], t[(i8 + 7) * 65 + j]);
    *(u32x4*)(dst + (size_t)j * R + r0 + i8) = o;
  }
  __syncthreads();
}

DI void win_map(int dc, int& c0, int& valid) {
  valid = 64;
  if (dc < 4) c0 = 64 * dc;
  else if (dc < 8) c0 = 256 + 64 * (dc - 4);
  else if (dc < 12) c0 = 768 + 64 * (dc - 8);
  else if (dc == 12) c0 = 1024;
  else if (dc == 13) c0 = 1088;
  else if (dc == 14) c0 = 1152;
  else if (dc == 15) c0 = 1280;
  else if (dc < 20) c0 = 1420 + 64 * (dc - 16);
  else if (dc < 24) c0 = 1676 + 64 * (dc - 20);
  else if (dc < 28) c0 = 2188 + 64 * (dc - 24);
  else if (dc < 30) c0 = 2444 + 64 * (dc - 28);
  else if (dc == 30) { c0 = 1408; valid = 12; }
  else if (dc == 31) { c0 = 0; valid = 0; }
  else if (dc < 36) c0 = 512 + 64 * (dc - 32);
  else if (dc == 36) c0 = 1216;
  else if (dc == 37) c0 = 1344;
  else if (dc < 42) c0 = 1932 + 64 * (dc - 38);
  else c0 = 2572 + 64 * (dc - 42);
}

DI void phase_prep(const Params& p, char* smem) {
  const int tid = my_tid(), G = gridDim.x;
  constexpr int N_WIN = NL * 44 * 16, N_WOUT = NL * 16 * 16, N_WUP = NL * 64 * 16, N_WDN = NL * 16 * 64, N_W1 = NL * 2 * 2 * 32, N_W2 = NL * 2 * 2;
  constexpr int N_ALL = N_WIN + N_WOUT + N_WUP + N_WDN + N_W1 + N_W2;
  for (int t = blockIdx.x; t < N_ALL; t += G) {
    int u = t;
    if (u < N_WIN) {
      const int l = u / 704, v = u % 704, dc = v / 16, rc = v % 16; int c0, valid; win_map(dc, c0, valid);
      cvt_tile(p.w_in + (size_t)l * DM * INC, INC, c0, valid, (bf16_t*)(p.ws + OFF_WIN) + ((size_t)l * NPROJ + dc * 64) * DM, DM, rc * 64, p.norm_attn + l * DM, smem);
      continue;
    }
    u -= N_WIN;
    if (u < N_WOUT) {
      const int l = u / 256, v = u % 256, dc = v / 16, rc = v % 16;
      cvt_tile(p.w_out + (size_t)l * DM * DM, DM, dc * 64, 64, (bf16_t*)(p.ws + OFF_WOUT) + ((size_t)l * DM + dc * 64) * DM, DM, rc * 64, p.g_mix + l * DM, smem);
      continue;
    }
    u -= N_WOUT;
    if (u < N_WUP) {
      const int l = u / 1024, v = u % 1024, dc = v / 16, rc = v % 16;
      cvt_tile(p.w_up + (size_t)l * DM * DFF, DFF, dc * 64, 64, (bf16_t*)(p.ws + OFF_WUP) + ((size_t)l * DFF + dc * 64) * DM, DM, rc * 64, p.norm_mlp + l * DM, smem);
      continue;
    }
    u -= N_WUP;
    if (u < N_WDN) {
      const int l = u / 1024, v = u % 1024, dc = v / 64, rc = v % 64;
      cvt_tile(p.w_down + (size_t)l * DFF * DM, DM, dc * 64, 64, (bf16_t*)(p.ws + OFF_WDN) + ((size_t)l * DM + dc * 64) * DFF, DFF, rc * 64, nullptr, smem);
      continue;
    }
    u -= N_WDN;
    if (u < N_W1) {
      const int lk = u / 64, v = u % 64, dc = v / 32, rc = v % 32, l = lk >> 1, kv = lk & 1;
      const float* src = (kv ? p.w1_v : p.w1_k) + (size_t)l * 2048 * 128;
      cvt_tile(src, 128, dc * 64, 64, (bf16_t*)(p.ws + OFF_W1T) + ((size_t)lk * 128 + dc * 64) * 2048, 2048, rc * 64, nullptr, smem);
      continue;
    }
    u -= N_W1;
    {
      const int lk = u / 2, rc = u % 2, l = lk >> 1, kv = lk & 1;
      const float* src = (kv ? p.w2_v : p.w2_k) + (size_t)l * 128 * 64;
      cvt_tile(src, 64, 0, 64, (bf16_t*)(p.ws + OFF_W2T) + (size_t)lk * 64 * 128, 128, rc * 64, nullptr, smem);
    }
  }
  if (blockIdx.x < 64) {
    const int lk = blockIdx.x >> 3, ch = blockIdx.x & 7, l = lk >> 1, kv = lk & 1, n = tid & 127, sub = tid >> 7;
    const float* pe = (kv ? p.pe_v : p.pe_k) + (size_t)l * 2048;
    const float* w1 = (kv ? p.w1_v : p.w1_k) + (size_t)l * 2048 * 128;
    const int f0 = ch * 256 + sub * 64;
    float sacc = 0.f;
#pragma unroll 16
    for (int f = f0; f < f0 + 64; ++f) sacc += pe[f] * w1[(size_t)f * 128 + n];
    ((float*)(p.ws + OFF_C1))[(lk * 32 + ch * 4 + sub) * 128 + n] = sacc;
  }
  if (blockIdx.x == 0) { ((int*)(p.ws + OFF_CTR))[tid] = 0; ((int*)(p.ws + OFF_CTR))[tid + 512] = 0; }
  const int lane = tid & 63, gw = blockIdx.x * 8 + (tid >> 6), nw = G * 8;
  float* ssA = (float*)(p.ws + OFF_SSA);
  bf16_t* xb = (bf16_t*)(p.ws + OFF_XB);
  for (int row = gw; row < NTOK; row += 2 * nw) {
    const int row2 = row + nw;
    f32x4 va[4], vb[4];
#pragma unroll
    for (int i = 0; i < 4; ++i) {
      va[i] = *(const f32x4*)(p.x + (size_t)row * DM + (i * 64 + lane) * 4);
      vb[i] = *(const f32x4*)(p.x + (size_t)(row2 < NTOK ? row2 : row) * DM + (i * 64 + lane) * 4);
    }
    float ssa = 0.f, ssb = 0.f;
#pragma unroll
    for (int i = 0; i < 4; ++i) {
      const size_t offa = (size_t)row * DM + (i * 64 + lane) * 4;
      u32x2 oa = {pk2(va[i][0], va[i][1]), pk2(va[i][2], va[i][3])};
      *(u32x2*)(xb + offa) = oa;
      const f32x4 ra = unpk4(oa);
      ssa += ra[0] * ra[0] + ra[1] * ra[1] + ra[2] * ra[2] + ra[3] * ra[3];
      if (row2 < NTOK) {
        const size_t offb = (size_t)row2 * DM + (i * 64 + lane) * 4;
        u32x2 ob = {pk2(vb[i][0], vb[i][1]), pk2(vb[i][2], vb[i][3])};
        *(u32x2*)(xb + offb) = ob;
        const f32x4 rb = unpk4(ob);
        ssb += rb[0] * rb[0] + rb[1] * rb[1] + rb[2] * rb[2] + rb[3] * rb[3];
      }
    }
#pragma unroll
    for (int o = 32; o > 0; o >>= 1) { ssa += __shfl_xor(ssa, o); ssb += __shfl_xor(ssb, o); }
    if (lane < 8) {
      ssA[(size_t)row * 8 + lane] = (lane == 0) ? ssa : 0.f;
      if (row2 < NTOK) ssA[(size_t)row2 * 8 + lane] = (lane == 0) ? ssb : 0.f;
    }
  }
}

enum { MODE_PROJ = 0, MODE_OUT = 1, MODE_UP = 2, MODE_DOWN = 3 };
typedef __attribute__((address_space(3))) unsigned lds_u32;
constexpr int HT = 128 * 64;

DI int lds_byte(int r, int c) {
  const int st = (r >> 4) * 2 + (c >> 5), rr = r & 15, cc = c & 31, ob = rr * 64 + cc * 2;
  return st * 1024 + (ob ^ (((ob >> 9) & 1) << 5));
}
DI void stage_rc(int b, int& R, int& C) {
  const int st = b / 1024, sb = b % 1024, swz = sb ^ (((sb >> 9) & 1) << 5);
  R = (st >> 1) * 16 + swz / 64; C = (st & 1) * 32 + (swz % 64) / 2;
}

template <int MODE>
DI void gemm_tile(const Params& p, const bf16_t* __restrict__ A, const bf16_t* __restrict__ Bt, int K, int brow, int bcol, int mp, int nt, bool vt, char* smem, const bf16_t* __restrict__ pf) {
  bf16_t* shm = (bf16_t*)smem;
  const int tid = my_tid();
  int go0, go1;
  { int r_, c_; stage_rc(tid * 16, r_, c_); go0 = r_ * K + c_; stage_rc(tid * 16 + 8192, r_, c_); go1 = r_ * K + c_; }
#define SA(b, h) (shm + ((b) * 2 + (h)) * HT)
#define SB(b, h) (shm + (4 + (b) * 2 + (h)) * HT)
#define STAGE(P, BASE, br, kt) do { const bf16_t* _gb = (BASE) + (long)(br) * K + (long)(kt) * 64; asm volatile("" : "+s"(_gb)); \
    __builtin_amdgcn_global_load_lds((const unsigned*)(_gb + go0), (lds_u32*)((char*)(P) + tid * 16), 16, 0, 0); \
    __builtin_amdgcn_global_load_lds((const unsigned*)(_gb + go1), (lds_u32*)((char*)(P) + tid * 16 + 8192), 16, 0, 0); } while (0)
#define LDA(dst, b, h) _Pragma("unroll") for (int m = 0; m < 4; ++m) _Pragma("unroll") for (int k = 0; k < 2; ++k) \
    dst[m][k] = *(const __attribute__((address_space(3))) bf16x8*)(aB + (((b) * 2 + (h)) * 16384 + m * 2048 + k * 1024))
#define LDB(dst, b, h) _Pragma("unroll") for (int n = 0; n < 2; ++n) _Pragma("unroll") for (int k = 0; k < 2; ++k) \
    dst[n][k] = *(const __attribute__((address_space(3))) bf16x8*)(bB + (((b) * 2 + (h)) * 16384 + n * 2048 + k * 1024))
#define MMA(ai, bj, At, Bq) do { __builtin_amdgcn_s_setprio(1); \
    _Pragma("unroll") for (int m = 0; m < 4; ++m) _Pragma("unroll") for (int n = 0; n < 2; ++n) _Pragma("unroll") for (int k = 0; k < 2; ++k) \
      acc[ai][bj][m][n] = __builtin_amdgcn_mfma_f32_16x16x32_bf16(At[m][k], Bq[n][k], acc[ai][bj][m][n], 0, 0, 0); \
    __builtin_amdgcn_s_setprio(0); } while (0)
#define WAIT_V(n) asm volatile("s_waitcnt vmcnt(" #n ")" ::: "memory")
#define WAIT_L(n) asm volatile("s_waitcnt lgkmcnt(" #n ")" ::: "memory")
#define BAR __builtin_amdgcn_s_barrier()
#define SCHED __builtin_amdgcn_sched_barrier(0)
  const int wid = tid >> 6, lane = tid & 63, wr = wid >> 2, wc = wid & 3, fr = lane & 15, fq = lane >> 4;
  const int laneoff = (fr * 64 + fq * 16) ^ ((fr >> 3) << 5);
  const __attribute__((address_space(3))) char* aB = (const __attribute__((address_space(3))) char*)smem + wr * 8192 + laneoff;
  const __attribute__((address_space(3))) char* bB = (const __attribute__((address_space(3))) char*)smem + 65536 + wc * 4096 + laneoff;
  f32x4 acc[2][2][4][2];
#pragma unroll
  for (int a = 0; a < 2; ++a)
#pragma unroll
    for (int b = 0; b < 2; ++b)
#pragma unroll
      for (int m = 0; m < 4; ++m)
#pragma unroll
        for (int n = 0; n < 2; ++n) acc[a][b][m][n] = (f32x4){0.f, 0.f, 0.f, 0.f};
  bf16x8 At[4][2], B0[2][2], B1[2][2];
  const int ntk = K / 64;
  const int m0 = mp * 256, n0 = nt * 256;
  float* rsl = (float*)(smem + 131072);
  float4 ssa = make_float4(0.f, 0.f, 0.f, 0.f);
  if (MODE == MODE_PROJ || MODE == MODE_UP)
    ssa = *(const float4*)((const float*)(p.ws + (MODE == MODE_UP ? OFF_SSB : OFF_SSA)) + (size_t)m0 * 8 + tid * 4);
  STAGE(SB(0, 0), Bt, bcol, 0); STAGE(SA(0, 0), A, brow, 0);
  STAGE(SB(0, 1), Bt, bcol + 128, 0); STAGE(SA(0, 1), A, brow + 128, 0);
  if (wr == 1) BAR;
  WAIT_V(4); BAR;
  STAGE(SB(1, 0), Bt, bcol, 1); STAGE(SA(1, 0), A, brow, 1); STAGE(SB(1, 1), Bt, bcol + 128, 1);
  WAIT_V(6); BAR;
  if (MODE == MODE_PROJ || MODE == MODE_UP) {
    float t = (ssa.x + ssa.y) + (ssa.z + ssa.w);
    t += __shfl_xor(t, 1);
    if ((tid & 1) == 0) rsl[tid >> 1] = rsqrtf(t * (1.f / 1024.f) + 1e-6f);
  }
  for (int t = 0; t < ntk - 2; t += 2) {
    LDB(B0, 0, 0); SCHED; LDA(At, 0, 0); STAGE(SA(1, 1), A, brow + 128, t + 1);
    WAIT_L(8); BAR; WAIT_L(0); MMA(0, 0, At, B0); BAR; SCHED;
    LDB(B1, 0, 1); STAGE(SB(0, 0), Bt, bcol, t + 2);
    BAR; WAIT_L(0); MMA(0, 1, At, B1); BAR;
    LDA(At, 0, 1); STAGE(SA(0, 0), A, brow, t + 2);
    BAR; WAIT_L(0); MMA(1, 0, At, B0); BAR; SCHED;
    STAGE(SB(0, 1), Bt, bcol + 128, t + 2);
    WAIT_V(6); BAR; MMA(1, 1, At, B1); BAR;
    LDB(B0, 1, 0); SCHED; LDA(At, 1, 0); STAGE(SA(0, 1), A, brow + 128, t + 2);
    WAIT_L(8); BAR; WAIT_L(0); MMA(0, 0, At, B0); BAR; SCHED;
    LDB(B1, 1, 1); STAGE(SB(1, 0), Bt, bcol, t + 3);
    BAR; WAIT_L(0); MMA(0, 1, At, B1); BAR;
    LDA(At, 1, 1); STAGE(SA(1, 0), A, brow, t + 3);
    BAR; WAIT_L(0); MMA(1, 0, At, B0); BAR; SCHED;
    STAGE(SB(1, 1), Bt, bcol + 128, t + 3);
    WAIT_V(6); BAR; MMA(1, 1, At, B1); BAR;
  }
  { LDB(B0, 0, 0); LDA(At, 0, 0); STAGE(SA(1, 1), A, brow + 128, ntk - 1);
    BAR; WAIT_L(0); MMA(0, 0, At, B0); BAR;
    LDB(B1, 0, 1); BAR; WAIT_L(0); MMA(0, 1, At, B1); BAR;
    LDA(At, 0, 1); WAIT_V(4); BAR; WAIT_L(0); MMA(1, 0, At, B0); MMA(1, 1, At, B1); BAR; }
  { LDB(B0, 1, 0); LDA(At, 1, 0); WAIT_V(2); BAR; WAIT_L(0); MMA(0, 0, At, B0); BAR;
    LDB(B1, 1, 1); WAIT_V(0); BAR; WAIT_L(0); MMA(0, 1, At, B1); BAR;
    LDA(At, 1, 1); BAR; WAIT_L(0); MMA(1, 0, At, B0); MMA(1, 1, At, B1); BAR; }
  if (wr == 0) BAR;
#undef SA
#undef SB
#undef STAGE
#undef LDA
#undef LDB
#undef MMA
  __syncthreads();
  unsigned pfv[8];
#pragma unroll
  for (int i = 0; i < 8; ++i) pfv[i] = 0u;
  if ((MODE == MODE_OUT || MODE == MODE_DOWN) && pf != nullptr) {
#pragma unroll
    for (int i = 0; i < 8; ++i)
      if (i < K / 512) pfv[i] = *(const unsigned*)(pf + (size_t)(i * 512 + tid) * 64);
  }
  float* st = (float*)smem;
  constexpr bool RESID = (MODE == MODE_OUT || MODE == MODE_DOWN);
  u32x2 xnx[4];
  if (RESID) {
#pragma unroll
    for (int pq = 0; pq < 4; ++pq) xnx[pq] = *(const u32x2*)((const bf16_t*)(p.ws + OFF_XB) + (size_t)(m0 + pq * 16 + (tid >> 5)) * DM + n0 + (tid & 31) * 4);
  }
#pragma unroll
  for (int ai = 0; ai < 2; ++ai)
#pragma unroll
    for (int bj = 0; bj < 2; ++bj) {
#pragma unroll
      for (int m = 0; m < 4; ++m)
#pragma unroll
        for (int n = 0; n < 2; ++n) *(f32x4*)(st + (wc * 32 + n * 16 + fr) * 132 + wr * 64 + m * 16 + fq * 4) = acc[ai][bj][m][n];
      __syncthreads();
#pragma unroll 1
      for (int pg = 0; pg < 2; ++pg) {
      u32x2 xo[4];
      if (RESID) {
#pragma unroll
        for (int pq = 0; pq < 4; ++pq) xo[pq] = xnx[pq];
        const int q = ai * 2 + bj, nq = pg ? q + 1 : q, npg = pg ^ 1;
        if (nq < 4) {
          const int nai = nq >> 1, nbj = nq & 1;
#pragma unroll
          for (int pq = 0; pq < 4; ++pq)
            xnx[pq] = *(const u32x2*)((const bf16_t*)(p.ws + OFF_XB) + (size_t)(m0 + nbj * 128 + (npg * 4 + pq) * 16 + (tid >> 5)) * DM + n0 + nai * 128 + (tid & 31) * 4);
        }
      }
#pragma unroll
      for (int pq = 0; pq < 4; ++pq) {
        const int pass = pg * 4 + pq;
        const int y = pass * 16 + (tid >> 5), x4 = (tid & 31) * 4;
        const f32x4 v = *(const f32x4*)(st + y * 132 + x4);
        if (MODE == MODE_PROJ) {
          if (vt) {
            const int vrow = (nt - 8) * 256 + bj * 128 + y, tk = m0 + ai * 128 + x4, b = tk >> 11, sq = tk & 2047;
            const f32x4 rr = *(const f32x4*)(rsl + ai * 128 + x4);
            u32x2 o = {pk2(v[0] * rr[0], v[1] * rr[1]), pk2(v[2] * rr[2], v[3] * rr[3])};
            *(u32x2*)((bf16_t*)(p.ws + OFF_VT) + ((size_t)(b * VROWS + vrow)) * SEQ + sq) = o;
          } else {
            const int tok = m0 + bj * 128 + y, col = n0 + ai * 128 + x4;
            const float rs = rsl[bj * 128 + y];
            if (col < QKW) {
              u32x2 o = {pk2(v[0] * rs, v[1] * rs), pk2(v[2] * rs, v[3] * rs)};
              *(u32x2*)((bf16_t*)(p.ws + OFF_QK) + (size_t)tok * QKW + col) = o;
            } else if (col < QKW + 16) {
              f32x4 o = {v[0] * rs, v[1] * rs, v[2] * rs, v[3] * rs};
              *(f32x4*)((float*)(p.ws + OFF_GATE) + (size_t)tok * 16 + (col - QKW)) = o;
            }
          }
        } else if (MODE == MODE_UP) {
          const int tok = m0 + bj * 128 + y, col = n0 + ai * 128 + x4;
          const float rs = rsl[bj * 128 + y];
          const float a0 = fmaxf(v[0] * rs, 0.f), a1 = fmaxf(v[1] * rs, 0.f), a2 = fmaxf(v[2] * rs, 0.f), a3 = fmaxf(v[3] * rs, 0.f);
          u32x2 o = {pk2(a0 * a0, a1 * a1), pk2(a2 * a2, a3 * a3)};
          *(u32x2*)((bf16_t*)(p.ws + OFF_U) + (size_t)tok * DFF + col) = o;
        } else {
          const int tok = m0 + bj * 128 + y, col = n0 + ai * 128 + x4;
          const f32x4 xs = unpk4(xo[pq]) + v;
          u32x2 o = {pk2(xs[0], xs[1]), pk2(xs[2], xs[3])};
          *(u32x2*)((bf16_t*)(p.ws + OFF_XB) + (size_t)tok * DM + col) = o;
          const f32x4 xn = unpk4(o);
          float ss = xn[0] * xn[0] + xn[1] * xn[1] + xn[2] * xn[2] + xn[3] * xn[3];
#pragma unroll
          for (int o2 = 16; o2 > 0; o2 >>= 1) ss += __shfl_xor(ss, o2);
          if ((tid & 31) == 0) ((float*)(p.ws + (MODE == MODE_OUT ? OFF_SSB : OFF_SSA)))[(size_t)tok * 8 + nt * 2 + ai] = ss;
        }
      }
      }
      __syncthreads();
    }
  if (MODE == MODE_OUT || MODE == MODE_DOWN) asm volatile("" :: "v"(pfv[0]), "v"(pfv[1]), "v"(pfv[2]), "v"(pfv[3]), "v"(pfv[4]), "v"(pfv[5]), "v"(pfv[6]), "v"(pfv[7]));
}

template <int MODE>
DI void phase_gemm(const Params& p, int l, char* smem) {
  const bf16_t* A; const bf16_t* W; int K, NT;
  if (MODE == MODE_PROJ) { A = (const bf16_t*)(p.ws + OFF_XB); W = (const bf16_t*)(p.ws + OFF_WIN) + (size_t)l * NPROJ * DM; K = DM; NT = 11; }
  else if (MODE == MODE_OUT) { A = (const bf16_t*)(p.ws + OFF_MIX); W = (const bf16_t*)(p.ws + OFF_WOUT) + (size_t)l * DM * DM; K = DM; NT = 4; }
  else if (MODE == MODE_UP) { A = (const bf16_t*)(p.ws + OFF_XB); W = (const bf16_t*)(p.ws + OFF_WUP) + (size_t)l * DFF * DM; K = DM; NT = 16; }
  else { A = (const bf16_t*)(p.ws + OFF_U); W = (const bf16_t*)(p.ws + OFF_WDN) + (size_t)l * DM * DFF; K = DFF; NT = 4; }
  const int G = gridDim.x;
  const bool xmap = (G & 7) == 0;
  const int xcd = blockIdx.x & 7, nb = xmap ? (G >> 3) : G, tot = xmap ? 32 * NT : 256 * NT;
  for (int L = xmap ? (int)(blockIdx.x >> 3) : (int)blockIdx.x; L < tot; L += nb) {
    int mp = (xmap ? xcd * 32 : 0) + L / NT, nt = L % NT;
    if (MODE == MODE_PROJ && xmap && nb == 32) {
      const int g = L / 88, t = L % 88;
      mp = xcd * 32 + g * 8 + (t & 7); nt = t >> 3;
    }
    if (MODE == MODE_UP && xmap && nb == 32) {
      const int it = L >> 5, j = L & 31;
      mp = xcd * 32 + (3 - (it >> 2)) * 8 + (j >> 2); nt = (it & 3) * 4 + (j & 3);
    }
    const bool vt = (MODE == MODE_PROJ) && (nt >= 8);
    const bf16_t* pf = nullptr;
    if ((MODE == MODE_OUT || MODE == MODE_DOWN) && xmap && L + nb < tot) {
      const int mpn = xcd * 32 + (L + nb) / NT;
      pf = A + ((size_t)mpn * 256 + (size_t)nt * 64) * K;
    }
    gemm_tile<MODE>(p, vt ? A : W, vt ? W : A, K, vt ? mp * 256 : nt * 256, vt ? nt * 256 : mp * 256, mp, nt, vt, smem, pf);
  }
}

DI float gelu_tanh(float x) {
  const float u = 0.7978845608028654f * (x + 0.044715f * x * x * x);
  const float e = __expf(2.f * u);
  const float t = 1.f - 2.f / (e + 1.f);
  return 0.5f * x * (1.f + t);
}

DI void phase_cmp(const Params& p, int l, char* smem) {
  const int tid = my_tid(), lane = tid & 63, w = (tid >> 6) & 3, kh = tid >> 8, r = lane & 31, h = lane >> 5;
  const bf16_t* QK = (const bf16_t*)(p.ws + OFF_QK);
  bf16_t* hid = (bf16_t*)smem;
  float* part = (float*)(smem + 16384);
  for (int u = blockIdx.x; u < 256; u += gridDim.x) {
    const int b = u >> 3, rt = (u >> 1) & 3, kv = u & 1, lk = l * 2 + kv;
    const int blk = min(rt * 32 + r, 126);
    const bf16_t* ap = QK + ((size_t)b * SEQ + 16 * blk) * QKW + (kv ? 832 : 768) + 8 * h;
    const bf16_t* bp = (const bf16_t*)(p.ws + OFF_W1T) + ((size_t)lk * 128 + 32 * w + r) * 2048 + 8 * h;
    f32x16 acc = zero16();
#pragma unroll 16
    for (int ks = kh * 64; ks < kh * 64 + 64; ++ks) {
      const bf16x8 a = *(const bf16x8*)(ap + (size_t)(ks >> 2) * QKW + (ks & 3) * 16);
      const bf16x8 bb = *(const bf16x8*)(bp + ks * 16);
      acc = MFMA(a, bb, acc);
    }
    if (kh == 1) {
#pragma unroll
      for (int i = 0; i < 16; ++i) part[i * 256 + (tid & 255)] = acc[i];
    }
    __syncthreads();
    if (kh == 0) {
      float c1 = 0.f;
#pragma unroll 8
      for (int q = 0; q < 32; ++q) c1 += ((const float*)(p.ws + OFF_C1))[(lk * 32 + q) * 128 + 32 * w + r];
#pragma unroll
      for (int i = 0; i < 16; ++i) {
        const int m = (i & 3) + 8 * (i >> 2) + 4 * h;
        hid[m * 136 + 32 * w + r] = f2bf(gelu_tanh(acc[i] + part[i * 256 + tid] + c1));
      }
    }
    __syncthreads();
    if (kh == 0 && w < 2) {
      const bf16_t* w2 = (const bf16_t*)(p.ws + OFF_W2T) + ((size_t)lk * 64 + 32 * w + r) * 128 + 8 * h;
      f32x16 a2 = zero16();
#pragma unroll
      for (int ks = 0; ks < 8; ++ks) {
        const bf16x8 a = *(const bf16x8*)(hid + r * 136 + ks * 16 + 8 * h);
        const bf16x8 bb = *(const bf16x8*)(w2 + ks * 16);
        a2 = MFMA(a, bb, a2);
      }
      if (kv == 0) {
        bf16_t* kc = (bf16_t*)(p.ws + OFF_KCMP) + (size_t)b * 128 * 64;
#pragma unroll
        for (int i = 0; i < 16; ++i) { const int m = (i & 3) + 8 * (i >> 2) + 4 * h; kc[(rt * 32 + m) * 64 + 32 * w + r] = f2bf(a2[i]); }
      } else {
        bf16_t* vc = (bf16_t*)(p.ws + OFF_VCMP) + (size_t)b * 64 * 128;
#pragma unroll
        for (int g = 0; g < 4; ++g) {
          u32x2 o = {pk2(a2[4 * g], a2[4 * g + 1]), pk2(a2[4 * g + 2], a2[4 * g + 3])};
          *(u32x2*)(vc + (32 * w + r) * 128 + rt * 32 + 8 * g + 4 * h) = o;
        }
      }
    }
    __syncthreads();
  }
}

struct FS { float m, l; f32x16 o0, o1; };
DI void fs_init(FS& s) { s.m = -1e30f; s.l = 0.f; s.o0 = zero16(); s.o1 = zero16(); }

template <int DQK>
DI void load_kv(bf16x8 (&kf)[DQK / 16], s16x4 (&va)[2][4], const bf16_t* __restrict__ Kp, int ldk, const bf16_t* __restrict__ Vt, int ldv, int kt, int r, int h) {
  const int key0 = kt * 32;
  const bf16_t* kp = Kp + (size_t)(key0 + r) * ldk + 8 * h;
#pragma unroll
  for (int ks = 0; ks < DQK / 16; ++ks) kf[ks] = *(const bf16x8*)(kp + 16 * ks);
  const bf16_t* v0p = Vt + (size_t)r * ldv + key0 + 4 * h;
  const bf16_t* v1p = v0p + (size_t)32 * ldv;
#pragma unroll
  for (int q4 = 0; q4 < 4; ++q4) { va[0][q4] = *(const s16x4*)(v0p + 8 * q4); va[1][q4] = *(const s16x4*)(v1p + 8 * q4); }
}

DI void make_cs2(f32x2 (&cs2)[8], float slope2, int kmul) {
#pragma unroll
  for (int j = 0; j < 8; ++j) {
    const int i0 = 2 * j, i1 = 2 * j + 1;
    cs2[j] = (f32x2){slope2 * (float)(kmul * ((i0 & 3) + 8 * (i0 >> 2))), slope2 * (float)(kmul * ((i1 & 3) + 8 * (i1 >> 2)))};
  }
}

struct PendPV { bf16x8 p0, p1, v00, v01, v10, v11; bool on; };
DI void pv_flush(FS& st, PendPV& pd) {
  if (pd.on) {
    st.o0 = MFMA(pd.v00, pd.p0, st.o0); st.o0 = MFMA(pd.v01, pd.p1, st.o0);
    st.o1 = MFMA(pd.v10, pd.p0, st.o1); st.o1 = MFMA(pd.v11, pd.p1, st.o1);
    pd.on = false;
  }
}

template <int DQK, int KMUL>
DI void flash_tile_math(FS& st, const bf16x8* qf, const bf16x8 (&kf)[DQK / 16], const s16x4 (&va)[2][4], int kt, int q0, int qpos, int kadd, unsigned window,
                        float scale2, float slope2, const f32x2 (&cs2)[8], unsigned selmask, bool use_sel, int h, PendPV& pd) {
  const int key0 = kt * 32;
  f32x16 s = zero16();
#pragma unroll
  for (int ks = 0; ks < DQK / 16; ++ks) s = MFMA(kf[ks], qf[ks], s);
  pv_flush(st, pd);
  const int dbase = qpos - kadd - KMUL * (key0 + 4 * h);
  const float zb = -slope2 * (float)dbase;
  const bool lsel = use_sel ? (((selmask >> (kt >> 1)) & 1u) != 0u) : true;
  bool need_mask = (KMUL != 1) || (key0 + 31 > q0) || ((unsigned)(q0 + 31 - key0) >= window);
  if (use_sel) need_mask = need_mask || (__ballot(lsel) != ~0ull);
  bf16x8 p0, p1;
  if (need_mask) {
    float z[16];
    float tmax = -1e30f;
#pragma unroll
    for (int i = 0; i < 16; ++i) {
      const int c = (i & 3) + 8 * (i >> 2);
      const int dist = dbase - KMUL * c;
      const bool ok = ((unsigned)dist < window) && lsel;
      float zi = fmaf(s[i], scale2, zb + slope2 * (float)(KMUL * c));
      zi = ok ? zi : -1e30f;
      z[i] = zi; tmax = fmaxf(tmax, zi);
    }
    tmax = fmaxf(tmax, __shfl_xor(tmax, 32));
    const float mn = fmaxf(st.m, tmax);
    const float alpha = ex2(st.m - mn);
    st.m = mn;
    float pv[16]; float ps = 0.f;
#pragma unroll
    for (int i = 0; i < 16; ++i) { float pi = ex2(z[i] - mn); pi = (z[i] > -1e29f) ? pi : 0.f; pv[i] = pi; ps += pi; }
    st.l = st.l * alpha + ps;
    st.o0 *= alpha; st.o1 *= alpha;
    p0 = pack8(pv[0], pv[1], pv[2], pv[3], pv[4], pv[5], pv[6], pv[7]);
    p1 = pack8(pv[8], pv[9], pv[10], pv[11], pv[12], pv[13], pv[14], pv[15]);
  } else {
    f32x2 u2[8];
    float tmax = -3e38f;
#pragma unroll
    for (int j = 0; j < 8; ++j) {
      const f32x2 sv = {s[2 * j], s[2 * j + 1]};
      u2[j] = sv * scale2 + cs2[j];
      tmax = fmaxf(fmaxf(u2[j][0], u2[j][1]), tmax);
    }
    tmax += zb;
    tmax = fmaxf(tmax, __shfl_xor(tmax, 32));
    if (__ballot(tmax > st.m) != 0ull) {
      const float mn = fmaxf(st.m, tmax);
      const float alpha = ex2(st.m - mn);
      st.m = mn; st.l *= alpha; st.o0 *= alpha; st.o1 *= alpha;
    }
    const float d = st.m - zb;
    f32x2 ps2 = {0.f, 0.f};
    unsigned pk[8];
#pragma unroll
    for (int j = 0; j < 8; ++j) {
      const f32x2 e = u2[j] - d;
      const f32x2 pp = {ex2(e[0]), ex2(e[1])};
      ps2 += pp;
      pk[j] = pk2(pp[0], pp[1]);
    }
    st.l += ps2[0] + ps2[1];
    p0 = __builtin_bit_cast(bf16x8, (u32x4){pk[0], pk[1], pk[2], pk[3]});
    p1 = __builtin_bit_cast(bf16x8, (u32x4){pk[4], pk[5], pk[6], pk[7]});
  }
  pd.p0 = p0; pd.p1 = p1;
  pd.v00 = cat8(va[0][0], va[0][1]); pd.v01 = cat8(va[0][2], va[0][3]); pd.v10 = cat8(va[1][0], va[1][1]); pd.v11 = cat8(va[1][2], va[1][3]);
  pd.on = true;
}

template <int DQK, int KMUL>
DI void flash_direct(FS& st, const bf16x8* qf, const bf16_t* __restrict__ Kp, int ldk, const bf16_t* __restrict__ Vt, int ldv, int kt_lo, int kt_hi,
                     int q0, int qpos, int kadd, unsigned window, float scale2, float slope2, int r, int h) {
  f32x2 cs2[8];
  make_cs2(cs2, slope2, KMUL);
  PendPV pd; pd.on = false;
  for (int kt = kt_hi; kt >= kt_lo; --kt) {
    bf16x8 kf[DQK / 16]; s16x4 va[2][4];
    load_kv<DQK>(kf, va, Kp, ldk, Vt, ldv, kt, r, h);
    flash_tile_math<DQK, KMUL>(st, qf, kf, va, kt, q0, qpos, kadd, window, scale2, slope2, cs2, 0u, false, h, pd);
  }
  pv_flush(st, pd);
}

template <int DQK, int NKV> struct StageCfg {
  static constexpr int KCH = 32 * DQK / 8, CS = KCH + 256, NCH = NKV * CS / 512, KST = DQK * 2 + 16, SS = 32 * KST + 64 * 80, BUFSZ = NKV * SS;
};
template <int DQK, int NKV, int NCHX>
DI void stage_load(u32x4 (&reg)[NCHX], const bf16_t* __restrict__ K, int ldk, int kstr, const bf16_t* __restrict__ V, int ldv, int vstr, int kt, int tid) {
  typedef StageCfg<DQK, NKV> C;
#pragma unroll
  for (int i = 0; i < C::NCH; ++i) {
    const int c = tid + 512 * i, sx = c / C::CS, wi = c % C::CS;
    const bf16_t* g;
    if (wi < C::KCH) { const int row = wi / (DQK / 8), ch = wi % (DQK / 8); g = K + (size_t)sx * kstr + (size_t)(kt * 32 + row) * ldk + ch * 8; }
    else { const int w2 = wi - C::KCH, row = w2 >> 2, ch = w2 & 3; g = V + (size_t)sx * vstr + (size_t)row * ldv + kt * 32 + ch * 8; }
    reg[i] = *(const u32x4*)g;
  }
}
template <int DQK, int NKV, int NCHX>
DI void stage_store(const u32x4 (&reg)[NCHX], char* buf, int tid) {
  typedef StageCfg<DQK, NKV> C;
#pragma unroll
  for (int i = 0; i < C::NCH; ++i) {
    const int c = tid + 512 * i, sx = c / C::CS, wi = c % C::CS;
    int off;
    if (wi < C::KCH) { const int row = wi / (DQK / 8), ch = wi % (DQK / 8); off = row * C::KST + ch * 16; }
    else { const int w2 = wi - C::KCH, row = w2 >> 2, ch = w2 & 3; off = 32 * C::KST + row * 80 + ch * 16; }
    *(u32x4*)(buf + sx * C::SS + off) = reg[i];
  }
}
template <int DQK>
DI void lds_kv(bf16x8 (&kf)[DQK / 16], s16x4 (&va)[2][4], const char* sb, int r, int h) {
  constexpr int KST = DQK * 2 + 16;
#pragma unroll
  for (int ks = 0; ks < DQK / 16; ++ks) kf[ks] = *(const bf16x8*)(sb + r * KST + (16 * ks + 8 * h) * 2);
  const char* vb = sb + 32 * KST + r * 80 + 8 * h;
#pragma unroll
  for (int q4 = 0; q4 < 4; ++q4) { va[0][q4] = *(const s16x4*)(vb + 16 * q4); va[1][q4] = *(const s16x4*)(vb + 32 * 80 + 16 * q4); }
}

DI unsigned wave_or32(unsigned v) {
  unsigned u = 0u;
  for (int j = 0; j < 32; ++j) if (__ballot(((v >> j) & 1u) != 0u) != 0ull) u |= 1u << j;
  return u;
}

template <int DQK, int NKV>
DI void flash_block(FS& st, const bf16x8* qf, int sidx, const bf16_t* __restrict__ K, int ldk, int kstr, const bf16_t* __restrict__ V, int ldv, int vstr,
                    int blk_lo, int blk_hi, int my_lo, int my_hi, int q0, int qpos, unsigned window, float scale2, float slope2,
                    unsigned selmask, bool use_sel, char* tbuf, unsigned* bum, int tid, int r, int h) {
  typedef StageCfg<DQK, NKV> C;
  unsigned umask = 0xffffffffu, bmask = 0xffffffffu;
  if (use_sel) {
    umask = wave_or32(selmask);
    if (tid == 0) *bum = 0u;
    __syncthreads();
    if ((tid & 63) == 0) atomicOr(bum, umask);
    __syncthreads();
    bmask = *bum;
  }
  f32x2 cs2[8];
  make_cs2(cs2, slope2, 1);
  PendPV pd; pd.on = false;
  int kt = blk_hi;
  if (use_sel) while (kt >= blk_lo && !((bmask >> (kt >> 1)) & 1u)) --kt;
  if (kt < blk_lo) return;
  int kt1 = kt - 1;
  if (use_sel) while (kt1 >= blk_lo && !((bmask >> (kt1 >> 1)) & 1u)) --kt1;
  u32x4 rg0[C::NCH], rg1[C::NCH];
  stage_load<DQK, NKV>(rg0, K, ldk, kstr, V, ldv, vstr, kt, tid);
  stage_load<DQK, NKV>(rg1, K, ldk, kstr, V, ldv, vstr, kt1 > blk_lo ? kt1 : blk_lo, tid);
  stage_store<DQK, NKV>(rg0, tbuf, tid);
  __syncthreads();
#define FB_ROUND(RA, RB, BUFC, BUFN) { \
    int kt2 = kt1 - 1; \
    if (use_sel) while (kt2 >= blk_lo && !((bmask >> (kt2 >> 1)) & 1u)) --kt2; \
    stage_load<DQK, NKV>(RA, K, ldk, kstr, V, ldv, vstr, kt2 > blk_lo ? kt2 : blk_lo, tid);     \
    if (kt >= my_lo && kt <= my_hi && ((umask >> (kt >> 1)) & 1u)) { \
      bf16x8 kf[DQK / 16]; s16x4 va[2][4]; \
      lds_kv<DQK>(kf, va, tbuf + (BUFC) * C::BUFSZ + sidx * C::SS, r, h); \
      flash_tile_math<DQK, 1>(st, qf, kf, va, kt, q0, qpos, 0, window, scale2, slope2, cs2, selmask, use_sel, h, pd); \
    } \
    if (kt1 >= blk_lo) stage_store<DQK, NKV>(RB, tbuf + (BUFN) * C::BUFSZ, tid); \
    asm volatile("s_waitcnt lgkmcnt(0)" ::: "memory"); __builtin_amdgcn_s_barrier(); asm volatile("" ::: "memory");   \
    kt = kt1; kt1 = kt2; }
  for (;;) {
    FB_ROUND(rg0, rg1, 0, 1);
    if (kt < blk_lo) break;
    FB_ROUND(rg1, rg0, 1, 0);
    if (kt < blk_lo) break;
  }
#undef FB_ROUND
  pv_flush(st, pd);
}

DI void sb_tile_math(f32x16& o0, f32x16& o1, float& R, const bf16x8* qf, const bf16x8 (&kf)[4], const s16x4 (&va)[2][4], int kt, int qpos, int h) {
  const int key0 = kt * 32;
  f32x16 s = zero16();
#pragma unroll
  for (int ks = 0; ks < 4; ++ks) s = MFMA(kf[ks], qf[ks], s);
  const int kb = key0 + 4 * h;
  float beta[16], om[16];
#pragma unroll
  for (int i = 0; i < 16; ++i) {
    const int c = (i & 3) + 8 * (i >> 2);
    const float zz = s[i] * 0.125f;
    const float e = ex2(-fabsf(zz) * LOG2E);
    const float rr = __builtin_amdgcn_rcpf(1.f + e);
    const float sm = e * rr;
    const bool pos = zz >= 0.f, ok = (kb + c) < qpos;
    beta[i] = ok ? (pos ? rr : sm) : 0.f;
    om[i] = ok ? (pos ? sm : rr) : 1.f;
  }
  float G[4], Go[4], T[4];
#pragma unroll
  for (int g = 0; g < 4; ++g) { G[g] = (om[4 * g] * om[4 * g + 1]) * (om[4 * g + 2] * om[4 * g + 3]); Go[g] = __shfl_xor(G[g], 32); T[g] = G[g] * Go[g]; }
  float after[4];
  after[3] = 1.f; after[2] = T[3]; after[1] = T[3] * T[2]; after[0] = after[1] * T[1];
  const float total = after[0] * T[0];
  float a[16];
#pragma unroll
  for (int g = 0; g < 4; ++g) {
    const float ag = (h == 0 ? Go[g] : 1.f) * after[g] * R;
    float t = ag;
    a[4 * g + 3] = beta[4 * g + 3] * t; t *= om[4 * g + 3];
    a[4 * g + 2] = beta[4 * g + 2] * t; t *= om[4 * g + 2];
    a[4 * g + 1] = beta[4 * g + 1] * t; t *= om[4 * g + 1];
    a[4 * g] = beta[4 * g] * t;
  }
  R *= total;
  const bf16x8 p0 = pack8(a[0], a[1], a[2], a[3], a[4], a[5], a[6], a[7]);
  const bf16x8 p1 = pack8(a[8], a[9], a[10], a[11], a[12], a[13], a[14], a[15]);
  o0 = MFMA(cat8(va[0][0], va[0][1]), p0, o0); o0 = MFMA(cat8(va[0][2], va[0][3]), p1, o0);
  o1 = MFMA(cat8(va[1][0], va[1][1]), p0, o1); o1 = MFMA(cat8(va[1][2], va[1][3]), p1, o1);
}

DI void sb_block(f32x16& o0, f32x16& o1, const bf16x8* qf, int sidx, const bf16_t* __restrict__ K, int ldk, int kstr, const bf16_t* __restrict__ V, int ldv, int vstr,
                 int blk_hi, int my_hi, int qpos, char* tbuf, int tid, int r, int h) {
  typedef StageCfg<64, 4> C;
  float R = 1.f;
  bool alive = true;
  u32x4 reg[C::NCH];
  int kt = blk_hi;
  stage_load<64, 4>(reg, K, ldk, kstr, V, ldv, vstr, kt, tid);
  stage_store<64, 4>(reg, tbuf, tid);
  __syncthreads();
  int it = 0;
  for (;;) {
    const bool more = kt > 0;
    if (more) stage_load<64, 4>(reg, K, ldk, kstr, V, ldv, vstr, kt - 1, tid);
    if (alive && kt <= my_hi) {
      bf16x8 kf[4]; s16x4 va[2][4];
      lds_kv<64>(kf, va, tbuf + (it & 1) * C::BUFSZ + sidx * C::SS, r, h);
      sb_tile_math(o0, o1, R, qf, kf, va, kt, qpos, h);
      alive = __ballot(R != 0.f) != 0ull;
    }
    if (more) stage_store<64, 4>(reg, tbuf + ((it + 1) & 1) * C::BUFSZ, tid);
    const int any = __syncthreads_or(alive ? 1 : 0);
    if (!more || !any) break;
    --kt; ++it;
  }
  __syncthreads();
}

DI float sigmoidf_(float x) { return 1.f / (1.f + __expf(-x)); }
DI void acc_store(float* accl, const f32x16& a, const f32x16& b, float f) {
#pragma unroll
  for (int i = 0; i < 16; ++i) { accl[i * 512] = a[i] * f; accl[(16 + i) * 512] = b[i] * f; }
}
DI void acc_add(float* accl, const f32x16& a, const f32x16& b, float f) {
#pragma unroll
  for (int i = 0; i < 16; ++i) { accl[i * 512] += a[i] * f; accl[(16 + i) * 512] += b[i] * f; }
}
DI void acc_final(const float* accl, f32x16& o0, f32x16& o1, const f32x16& a, const f32x16& b, float f) {
#pragma unroll
  for (int i = 0; i < 16; ++i) { o0[i] = accl[i * 512] + a[i] * f; o1[i] = accl[(16 + i) * 512] + b[i] * f; }
}

DI void attn_unit(const Params& p, int l, int b, int qtp, int grp, char* smem) {
  const int tid = my_tid(), lane = tid & 63, w = (tid >> 6) & 3, half = tid >> 8, r = lane & 31, h = lane >> 5;
  const int qt = qtp * 2 + half;
  const bf16_t* QK = (const bf16_t*)(p.ws + OFF_QK);
  const bf16_t* VT = (const bf16_t*)(p.ws + OFF_VT) + (size_t)b * VROWS * SEQ;
  const size_t tok0 = (size_t)b * SEQ;
  const int q0 = qt * 32, qpos = q0 + r;
  const bf16_t* qrow = QK + (tok0 + qpos) * QKW + 8 * h;
  const bf16_t* Kb = QK + tok0 * QKW;
  float* imp = (float*)(smem + half * 16896);
  unsigned* selm = (unsigned*)(smem + 33792 + half * 128);
  float* gn = (float*)(smem + 34048 + half * 512);
  float* accl = (float*)(smem + 35328) + tid;
  unsigned* bum = (unsigned*)(smem + 35076);
  char* tbuf = smem + (grp == 2 ? 35328 : 100864);
  const int q0b = qtp * 64, qtb = qtp * 2 + 1;
  const unsigned INFW = 0x7fffffffu;
  f32x16 o0 = zero16(), o1 = zero16();
  bf16x8 qf[4];
  bool group_norm = true;

  if (grp == 0) {
    const float lam_init = 0.8f - 0.6f * __expf(-0.3f * (float)l);
    float d1 = 0.f, d2 = 0.f;
    for (int i = 0; i < 32; ++i) { d1 += p.lq1[l * 32 + i] * p.lk1[l * 32 + i]; d2 += p.lq2[l * 32 + i] * p.lk2[l * 32 + i]; }
    const float lam = __expf(d1) - __expf(d2) + lam_init;
    const float slope2 = ex2(-(2.f / 3.f) * (float)(3 * w + 2)) * LOG2E;
    const float scale2 = 0.17677669529663687f * LOG2E;
#pragma unroll 1
    for (int c = 0; c < 2; ++c) {
      qf[0] = *(const bf16x8*)(qrow + 1024 + w * 64 + c * 32);
      qf[1] = *(const bf16x8*)(qrow + 1024 + w * 64 + c * 32 + 16);
      FS st; fs_init(st);
      flash_block<32, 4>(st, qf, w, Kb + 1280 + c * 32, QKW, 64, VT + (size_t)384 * SEQ, SEQ, 64 * SEQ, 0, qtb, 0, qt, q0, qpos, INFW, scale2, slope2, 0u, false, tbuf, bum, tid, r, h);
      const float lt = st.l + __shfl_xor(st.l, 32);
      if (c == 0) acc_store(accl, st.o0, st.o1, 1.f / lt);
      else acc_add(accl, st.o0, st.o1, -lam / lt);
    }
#pragma unroll
    for (int i = 0; i < 16; ++i) { o0[i] = accl[i * 512]; o1[i] = accl[(16 + i) * 512]; }
    float ss = 0.f;
#pragma unroll
    for (int i = 0; i < 16; ++i) ss += o0[i] * o0[i] + o1[i] * o1[i];
    ss += __shfl_xor(ss, 32);
    const float sc = rsqrtf(ss * (1.f / 64.f) + EPS) * (1.f - lam_init);
    o0 *= sc; o1 *= sc;
    group_norm = false;
  } else if (grp == 1) {
#pragma unroll
    for (int ks = 0; ks < 4; ++ks) qf[ks] = *(const bf16x8*)(qrow + 512 + w * 64 + 16 * ks);
    const float slope2 = ex2(-(2.f / 3.f) * (float)(3 * w + 1)) * LOG2E;
    const float scale2 = 0.125f * LOG2E;
    const float* gp = (const float*)(p.ws + OFF_GATE) + (tok0 + qpos) * 16 + w * 3;
    const float g0 = sigmoidf_(gp[0]), g1 = sigmoidf_(gp[1]), g2 = sigmoidf_(gp[2]);
    const bf16_t* kc = (const bf16_t*)(p.ws + OFF_KCMP) + (size_t)b * 128 * 64;
    const bf16_t* vc = (const bf16_t*)(p.ws + OFF_VCMP) + (size_t)b * 64 * 128;
    const int ktc = min(3, qt >> 4);
    {
      FS st; fs_init(st);
      flash_direct<64, 16>(st, qf, kc, 64, vc, 128, 0, ktc, q0, qpos, 31, INFW, scale2, slope2, r, h);
      const float lt = st.l + __shfl_xor(st.l, 32);
      const float inv = lt > 0.f ? 1.f / lt : 0.f;
      acc_store(accl, st.o0, st.o1, inv * g0);
      float* impw = imp + (w * 32 + r) * 33;
      for (int kt = 0; kt < 4; ++kt) {
        if (kt <= ktc) {
          const int key0 = kt * 32;
          const bf16_t* kp = kc + (size_t)(key0 + r) * 64 + 8 * h;
          f32x16 s = zero16();
#pragma unroll
          for (int ks = 0; ks < 4; ++ks) s = MFMA(*(const bf16x8*)(kp + 16 * ks), qf[ks], s);
          const int dbase = qpos - 31 - 16 * (key0 + 4 * h);
          const float zb = -slope2 * (float)dbase;
#pragma unroll
          for (int g = 0; g < 4; ++g) {
            float sum4 = 0.f;
#pragma unroll
            for (int k = 0; k < 4; ++k) {
              const int c = k + 8 * g;
              const int dist = dbase - 16 * c;
              const float zi = fmaf(s[4 * g + k], scale2, zb + slope2 * (float)(16 * c));
              const float pi = (dist >= 0) ? ex2(zi - st.m) * inv : 0.f;
              sum4 += pi;
            }
            impw[8 * kt + 2 * g + h] = sum4;
          }
        } else {
#pragma unroll
          for (int g = 0; g < 4; ++g) impw[8 * kt + 2 * g + h] = 0.f;
        }
      }
    }
    __syncthreads();
    if ((tid & 255) < 32) {
      const int cur = qt >> 1;
      const float* scp = imp + (tid & 255) * 33;
      float sc[32];
#pragma unroll
      for (int j = 0; j < 32; ++j) {
        const float v = scp[j] + scp[j + 32 * 33] + scp[j + 2 * 32 * 33] + scp[j + 3 * 32 * 33];
        const bool forced = (j == 0) || (j == cur) || (j == cur - 1);
        sc[j] = (j > cur) ? -1e30f : (forced ? 1e9f : v);
      }
      unsigned mask = 0u;
#pragma unroll 1
      for (int n = 0; n < 8; ++n) {
        float best = -INFINITY; int bj = 0;
#pragma unroll
        for (int j = 0; j < 32; ++j) { const bool gt = sc[j] > best; best = gt ? sc[j] : best; bj = gt ? j : bj; }
#pragma unroll
        for (int j = 0; j < 32; ++j) sc[j] = (j == bj) ? -INFINITY : sc[j];
        mask |= 1u << bj;
      }
      selm[tid & 255] = mask;
    }
    __syncthreads();
    const unsigned selmask = selm[r];
    {
      FS st; fs_init(st);
      flash_block<64, 1>(st, qf, 0, Kb + 896, QKW, 0, VT + (size_t)256 * SEQ, SEQ, 0, 0, qtb, 0, qt, q0, qpos, INFW, scale2, slope2, selmask, true, tbuf, bum, tid, r, h);
      const float lt = st.l + __shfl_xor(st.l, 32);
      acc_add(accl, st.o0, st.o1, g1 / lt);
    }
    {
      FS st; fs_init(st);
      const int lo = q0 >= 511 ? ((q0 - 511) >> 5) : 0, lob = q0b >= 511 ? ((q0b - 511) >> 5) : 0;
      flash_block<64, 1>(st, qf, 0, Kb + 960, QKW, 0, VT + (size_t)320 * SEQ, SEQ, 0, lob, qtb, lo, qt, q0, qpos, 512u, scale2, slope2, 0u, false, tbuf, bum, tid, r, h);
      const float lt = st.l + __shfl_xor(st.l, 32);
      acc_final(accl, o0, o1, st.o0, st.o1, g2 / lt);
    }
  } else if (grp == 2) {
#pragma unroll
    for (int ks = 0; ks < 4; ++ks) qf[ks] = *(const bf16x8*)(qrow + w * 64 + 16 * ks);
    sb_block(o0, o1, qf, w, Kb + 256, QKW, 64, VT, SEQ, 64 * SEQ, qtb, qt, qpos, tbuf, tid, r, h);
  } else {
#pragma unroll
    for (int ks = 0; ks < 4; ++ks) qf[ks] = *(const bf16x8*)(qrow + 1536 + w * 64 + 16 * ks);
    const float slope2 = ex2(-(2.f / 3.f) * (float)(3 * w + 3)) * LOG2E;
    const float scale2 = 0.125f * LOG2E;
    FS st; fs_init(st);
    const int lo = q0 >= 127 ? ((q0 - 127) >> 5) : 0, lob = q0b >= 127 ? ((q0b - 127) >> 5) : 0;
    flash_block<64, 2>(st, qf, w >> 1, Kb + 1792, QKW, 64, VT + (size_t)640 * SEQ, SEQ, 64 * SEQ, lob, qtb, lo, qt, q0, qpos, 128u, scale2, slope2, 0u, false, tbuf, bum, tid, r, h);
    float lt = st.l + __shfl_xor(st.l, 32);
    lt += ex2(p.sinks[l * 4 + w] * LOG2E - st.m);
    const float f = 1.f / lt;
    o0 = st.o0 * f; o1 = st.o1 * f;
  }

  if (group_norm) {
    float ss = 0.f;
#pragma unroll
    for (int i = 0; i < 16; ++i) ss += o0[i] * o0[i] + o1[i] * o1[i];
    ss += __shfl_xor(ss, 32);
    if (h == 0) gn[w * 32 + r] = ss;
    __syncthreads();
    const float tot = gn[r] + gn[32 + r] + gn[64 + r] + gn[96 + r];
    const float sc = rsqrtf(tot * (1.f / 256.f) + EPS);
    o0 *= sc; o1 *= sc;
  }
  const int gcol = (grp == 2 ? 0 : grp == 1 ? 256 : grp == 0 ? 512 : 768) + w * 64 + 4 * h;
  bf16_t* mrow = (bf16_t*)(p.ws + OFF_MIX) + (tok0 + qpos) * DM + gcol;
#pragma unroll
  for (int g = 0; g < 4; ++g) {
    u32x2 a = {pk2(o0[4 * g], o0[4 * g + 1]), pk2(o0[4 * g + 2], o0[4 * g + 3])};
    u32x2 c = {pk2(o1[4 * g], o1[4 * g + 1]), pk2(o1[4 * g + 2], o1[4 * g + 3])};
    *(u32x2*)(mrow + 8 * g) = a;
    *(u32x2*)(mrow + 32 + 8 * g) = c;
  }
  __syncthreads();
}

DI void phase_attn(const Params& p, int l, char* smem) {
  int* ctr = (int*)(p.ws + OFF_CTR) + l * 8;
  int* su = (int*)(smem + 35072);
  const int xcd = blockIdx.x & 7;
  int k = 0;
  for (;;) {
    if (my_tid() == 0) {
      int U = -1;
      for (; k < 8; ++k) {
        const int x = (xcd + k) & 7;
        const int v = atomicAdd(ctr + x, 1);
        if (v < 512) { U = x * 512 + v; break; }
      }
      *su = U;
    }
    __syncthreads();
    const int U = *su;
    __syncthreads();
    if (U < 0) break;
    const int x = U >> 9, v = U & 511;
    const int b = x * 4 + 3 - (v >> 7), wq = v & 127;
    attn_unit(p, l, b, 31 - (wq & 31), wq >> 5, smem);
  }
}

DI void phase_final(const Params& p) {
  const float* ssA = (const float*)(p.ws + OFF_SSA);
  const int lane = my_tid() & 63, gw = blockIdx.x * 8 + (my_tid() >> 6), nw = gridDim.x * 8;
  for (int row = gw; row < NTOK; row += nw) {
    const float rs = row_rstd(ssA, row);
#pragma unroll
    for (int i = 0; i < 4; ++i) {
      const int c = (i * 64 + lane) * 4;
      f32x4 v = unpk4(*(const u32x2*)((const bf16_t*)(p.ws + OFF_XB) + (size_t)row * DM + c));
      const f32x4 g = *(const f32x4*)(p.norm_final + c);
      v = v * rs * g;
      *(f32x4*)(p.xw + (size_t)row * DM + c) = v;
    }
  }
}

DI void grid_bar2(unsigned* bar, unsigned epoch, unsigned per_group) {
  __syncthreads();
  if (my_tid() == 0) {
    __threadfence();
    const unsigned x = blockIdx.x & 7u;
    const unsigned prev = __hip_atomic_fetch_add(bar + x * 32, 1u, __ATOMIC_ACQ_REL, __HIP_MEMORY_SCOPE_AGENT);
    if (prev == per_group - 1u) {
      __hip_atomic_store(bar + x * 32, 0u, __ATOMIC_RELAXED, __HIP_MEMORY_SCOPE_AGENT);
      const unsigned pg = __hip_atomic_fetch_add(bar + 256, 1u, __ATOMIC_ACQ_REL, __HIP_MEMORY_SCOPE_AGENT);
      if (pg == 7u) {
        __hip_atomic_store(bar + 256, 0u, __ATOMIC_RELAXED, __HIP_MEMORY_SCOPE_AGENT);
        for (unsigned j = 0; j < 8u; ++j) __hip_atomic_store(bar + (9u + j) * 32, epoch, __ATOMIC_RELEASE, __HIP_MEMORY_SCOPE_AGENT);
      }
    }
    while (__hip_atomic_load(bar + (9u + x) * 32, __ATOMIC_RELAXED, __HIP_MEMORY_SCOPE_AGENT) < epoch) __builtin_amdgcn_s_sleep(1);
    __threadfence();
    asm volatile("s_waitcnt vmcnt(0)" ::: "memory");
  }
  __syncthreads();
}

__global__ void __launch_bounds__(512, 2) mega(Params p) {
  __shared__ __attribute__((aligned(16))) char smem[163328];
  cg::grid_group grid = cg::this_grid();
  for (int ph = p.ph_lo; ph < p.ph_hi; ++ph) {
    if (ph == 0) phase_prep(p, smem);
    else if (ph == 25) phase_final(p);
    else {
      const int l = (ph - 1) / 6, k = (ph - 1) % 6;
      if (k == 0) phase_gemm<MODE_PROJ>(p, l, smem);
      else if (k == 1) phase_cmp(p, l, smem);
      else if (k == 2) phase_attn(p, l, smem);
      else if (k == 3) phase_gemm<MODE_OUT>(p, l, smem);
      else if (k == 4) phase_gemm<MODE_UP>(p, l, smem);
      else phase_gemm<MODE_DOWN>(p, l, smem);
    }
    if (ph + 1 < p.ph_hi) {
      if (ph == p.ph_lo || (gridDim.x & 7u) != 0u) grid.sync();
      else grid_bar2((unsigned*)(p.ws + OFF_CTR + 1024), (unsigned)(ph - p.ph_lo), gridDim.x >> 3);
    }
  }
}

extern "C" void kernel_launch(void* const* d_in, const int* in_sizes, int n_in, void* d_out, int out_size, void* d_ws, size_t ws_size, hipStream_t stream) {
  static int grid_blocks = 0;
  if (!grid_blocks) {
    int dev = 0, cus = 0, per_cu = 0;
    hipGetDevice(&dev);
    hipDeviceGetAttribute(&cus, hipDeviceAttributeMultiprocessorCount, dev);
    hipOccupancyMaxActiveBlocksPerMultiprocessor(&per_cu, mega, 512, 0);
    if (per_cu > 1) per_cu = 1;
    if (per_cu < 1) per_cu = 1;
    grid_blocks = cus * per_cu;
  }
  Params p{};
  const float** f = (const float**)&p;
  for (int i = 0; i < 20; ++i) f[i] = (const float*)d_in[i];
  p.xw = (float*)d_out;
  p.ws = (char*)d_ws;
  p.ph_lo = 0; p.ph_hi = 26;
  void* args[] = {&p};
  hipError_t e = hipLaunchCooperativeKernel((void*)mega, dim3(grid_blocks), dim3(512), args, 0, stream);
  if (e != hipSuccess) fprintf(stderr, "cooperative launch failed: %s (grid %d)\n", hipGetErrorString(e), grid_blocks);
}
```

```cpp
#include <hip/hip_runtime.h>
#include <hip/hip_cooperative_groups.h>
#include <cstdio>
namespace cg = cooperative_groups;

typedef unsigned short bf16_t;
typedef short bf16x8 __attribute__((ext_vector_type(8)));
typedef short s16x4 __attribute__((ext_vector_type(4)));
typedef float f32x16 __attribute__((ext_vector_type(16)));
typedef float f32x4 __attribute__((ext_vector_type(4)));
typedef float f32x2 __attribute__((ext_vector_type(2)));
typedef unsigned u32x4 __attribute__((ext_vector_type(4)));
typedef unsigned u32x2 __attribute__((ext_vector_type(2)));
typedef __bf16 bf2_t __attribute__((ext_vector_type(2)));
#define DI __device__ __forceinline__
#define MFMA(a, b, c) __builtin_amdgcn_mfma_f32_32x32x16_bf16((a), (b), (c), 0, 0, 0)

constexpr int NTOK = 65536, SEQ = 2048, NB = 32, DM = 1024, DFF = 4096, NL = 4;
constexpr int NPROJ = 2816, QKW = 1920, VROWS = 768, INC = 2700;
constexpr float EPS = 1e-6f, LOG2E = 1.4426950408889634f;

constexpr size_t SZ_WIN = (size_t)NL * NPROJ * DM * 2, SZ_WOUT = (size_t)NL * DM * DM * 2, SZ_WUP = (size_t)NL * DFF * DM * 2, SZ_WDN = SZ_WUP;
constexpr size_t SZ_W1T = (size_t)NL * 2 * 128 * 2048 * 2, SZ_W2T = (size_t)NL * 2 * 64 * 128 * 2, SZ_C1 = 8 * 32 * 128 * 4;
constexpr size_t OFF_WIN = 0, OFF_WOUT = OFF_WIN + SZ_WIN, OFF_WUP = OFF_WOUT + SZ_WOUT, OFF_WDN = OFF_WUP + SZ_WUP;
constexpr size_t OFF_W1T = OFF_WDN + SZ_WDN, OFF_W2T = OFF_W1T + SZ_W1T, OFF_C1 = OFF_W2T + SZ_W2T;
constexpr size_t OFF_SSA = OFF_C1 + SZ_C1, OFF_SSB = OFF_SSA + NTOK * 32, OFF_CTR = OFF_SSB + NTOK * 32;
constexpr size_t OFF_XB = OFF_CTR + 4096, OFF_R = OFF_XB + (size_t)NTOK * DM * 2;
constexpr size_t OFF_QK = OFF_R, OFF_VT = OFF_QK + (size_t)NTOK * QKW * 2, OFF_GATE = OFF_VT + (size_t)NB * VROWS * SEQ * 2;
constexpr size_t OFF_KCMP = OFF_GATE + (size_t)NTOK * 16 * 4, OFF_VCMP = OFF_KCMP + (size_t)NB * 128 * 64 * 2, OFF_MIX = OFF_VCMP + (size_t)NB * 64 * 128 * 2;
constexpr size_t OFF_U = OFF_R;

struct Params {
  const float *x, *norm_attn, *w_in, *pe_k, *w1_k, *w2_k, *pe_v, *w1_v, *w2_v, *lq1, *lk1, *lq2, *lk2, *sinks, *g_mix, *w_out, *norm_mlp, *w_up, *w_down, *norm_final;
  float* xw;
  char* ws;
  int ph_lo, ph_hi;
};

DI int my_tid() { int t = threadIdx.x; asm volatile("" : "+v"(t)); return t; }
DI float row_rstd(const float* ss, int tok) {
  const float4 a = *(const float4*)(ss + (size_t)tok * 8), b = *(const float4*)(ss + (size_t)tok * 8 + 4);
  const float t = ((a.x + a.y) + (a.z + a.w)) + ((b.x + b.y) + (b.z + b.w));
  return rsqrtf(t * (1.f / 1024.f) + 1e-6f);
}
DI unsigned pk2(float a, float b) { f32x2 v = {a, b}; bf2_t r = __builtin_convertvector(v, bf2_t); return __builtin_bit_cast(unsigned, r); }
DI f32x4 unpk4(u32x2 u) { f32x4 r = {__uint_as_float(u[0] << 16), __uint_as_float(u[0] & 0xffff0000u), __uint_as_float(u[1] << 16), __uint_as_float(u[1] & 0xffff0000u)}; return r; }
DI bf16_t f2bf(float a) { return (bf16_t)(pk2(a, 0.f) & 0xffffu); }
DI float ex2(float x) { return __builtin_amdgcn_exp2f(x); }
DI bf16x8 cat8(s16x4 lo, s16x4 hi) { return __builtin_shufflevector(lo, hi, 0, 1, 2, 3, 4, 5, 6, 7); }
DI f32x16 zero16() { f32x16 z; _Pragma("unroll") for (int i = 0; i < 16; ++i) z[i] = 0.f; return z; }
DI bf16x8 pack8(float a0, float a1, float a2, float a3, float a4, float a5, float a6, float a7) {
  u32x4 u = {pk2(a0, a1), pk2(a2, a3), pk2(a4, a5), pk2(a6, a7)};
  return __builtin_bit_cast(bf16x8, u);
}

DI void cvt_tile(const float* __restrict__ src, int C, int c0, int valid, bf16_t* __restrict__ dst, int R, int r0, const float* __restrict__ gain, char* smem) {
  float* t = (float*)smem;
  const int tid = my_tid();
  {
    const int col = tid & 63;
    float v[8], g[8];
#pragma unroll
    for (int i = 0; i < 8; ++i) {
      const int row = i * 8 + (tid >> 6);
      v[i] = (col < valid) ? src[(size_t)(r0 + row) * C + c0 + col] : 0.f;
      g[i] = gain ? gain[r0 + row] : 1.f;
    }
#pragma unroll
    for (int i = 0; i < 8; ++i) t[(i * 8 + (tid >> 6)) * 65 + col] = v[i] * g[i];
  }
  __syncthreads();
  {
    const int j = tid >> 3, i8 = (tid & 7) * 8;
    u32x4 o;
    o[0] = pk2(t[(i8 + 0) * 65 + j], t[(i8 + 1) * 65 + j]); o[1] = pk2(t[(i8 + 2) * 65 + j], t[(i8 + 3) * 65 + j]);
    o[2] = pk2(t[(i8 + 4) * 65 + j], t[(i8 + 5) * 65 + j]); o[3] = pk2(t[(i8 + 6) * 65 + j], t[(i8 + 7) * 65 + j]);
    *(u32x4*)(dst + (size_t)j * R + r0 + i8) = o;
  }
  __syncthreads();
}

DI void win_map(int dc, int& c0, int& valid) {
  valid = 64;
  if (dc < 4) c0 = 64 * dc;
  else if (dc < 8) c0 = 256 + 64 * (dc - 4);
  else if (dc < 12) c0 = 768 + 64 * (dc - 8);
  else if (dc == 12) c0 = 1024;
  else if (dc == 13) c0 = 1088;
  else if (dc == 14) c0 = 1152;
  else if (dc == 15) c0 = 1280;
  else if (dc < 20) c0 = 1420 + 64 * (dc - 16);
  else if (dc < 24) c0 = 1676 + 64 * (dc - 20);
  else if (dc < 28) c0 = 2188 + 64 * (dc - 24);
  else if (dc < 30) c0 = 2444 + 64 * (dc - 28);
  else if (dc == 30) { c0 = 1408; valid = 12; }
  else if (dc == 31) { c0 = 0; valid = 0; }
  else if (dc < 36) c0 = 512 + 64 * (dc - 32);
  else if (dc == 36) c0 = 1216;
  else if (dc == 37) c0 = 1344;
  else if (dc < 42) c0 = 1932 + 64 * (dc - 38);
  else c0 = 2572 + 64 * (dc - 42);
}

DI void phase_prep(const Params& p, char* smem) {
  const int tid = my_tid(), G = gridDim.x;
  constexpr int N_WIN = NL * 44 * 16, N_WOUT = NL * 16 * 16, N_WUP = NL * 64 * 16, N_WDN = NL * 16 * 64, N_W1 = NL * 2 * 2 * 32, N_W2 = NL * 2 * 2;
  constexpr int N_ALL = N_WIN + N_WOUT + N_WUP + N_WDN + N_W1 + N_W2;
  for (int t = blockIdx.x; t < N_ALL; t += G) {
    int u = t;
    if (u < N_WIN) {
      const int l = u / 704, v = u % 704, dc = v / 16, rc = v % 16; int c0, valid; win_map(dc, c0, valid);
      cvt_tile(p.w_in + (size_t)l * DM * INC, INC, c0, valid, (bf16_t*)(p.ws + OFF_WIN) + ((size_t)l * NPROJ + dc * 64) * DM, DM, rc * 64, p.norm_attn + l * DM, smem);
      continue;
    }
    u -= N_WIN;
    if (u < N_WOUT) {
      const int l = u / 256, v = u % 256, dc = v / 16, rc = v % 16;
      cvt_tile(p.w_out + (size_t)l * DM * DM, DM, dc * 64, 64, (bf16_t*)(p.ws + OFF_WOUT) + ((size_t)l * DM + dc * 64) * DM, DM, rc * 64, p.g_mix + l * DM, smem);
      continue;
    }
    u -= N_WOUT;
    if (u < N_WUP) {
      const int l = u / 1024, v = u % 1024, dc = v / 16, rc = v % 16;
      cvt_tile(p.w_up + (size_t)l * DM * DFF, DFF, dc * 64, 64, (bf16_t*)(p.ws + OFF_WUP) + ((size_t)l * DFF + dc * 64) * DM, DM, rc * 64, p.norm_mlp + l * DM, smem);
      continue;
    }
    u -= N_WUP;
    if (u < N_WDN) {
      const int l = u / 1024, v = u % 1024, dc = v / 64, rc = v % 64;
      cvt_tile(p.w_down + (size_t)l * DFF * DM, DM, dc * 64, 64, (bf16_t*)(p.ws + OFF_WDN) + ((size_t)l * DM + dc * 64) * DFF, DFF, rc * 64, nullptr, smem);
      continue;
    }
    u -= N_WDN;
    if (u < N_W1) {
      const int lk = u / 64, v = u % 64, dc = v / 32, rc = v % 32, l = lk >> 1, kv = lk & 1;
      const float* src = (kv ? p.w1_v : p.w1_k) + (size_t)l * 2048 * 128;
      cvt_tile(src, 128, dc * 64, 64, (bf16_t*)(p.ws + OFF_W1T) + ((size_t)lk * 128 + dc * 64) * 2048, 2048, rc * 64, nullptr, smem);
      continue;
    }
    u -= N_W1;
    {
      const int lk = u / 2, rc = u % 2, l = lk >> 1, kv = lk & 1;
      const float* src = (kv ? p.w2_v : p.w2_k) + (size_t)l * 128 * 64;
      cvt_tile(src, 64, 0, 64, (bf16_t*)(p.ws + OFF_W2T) + (size_t)lk * 64 * 128, 128, rc * 64, nullptr, smem);
    }
  }
  if (blockIdx.x < 64) {
    const int lk = blockIdx.x >> 3, ch = blockIdx.x & 7, l = lk >> 1, kv = lk & 1, n = tid & 127, sub = tid >> 7;
    const float* pe = (kv ? p.pe_v : p.pe_k) + (size_t)l * 2048;
    const float* w1 = (kv ? p.w1_v : p.w1_k) + (size_t)l * 2048 * 128;
    const int f0 = ch * 256 + sub * 64;
    float sacc = 0.f;
#pragma unroll 16
    for (int f = f0; f < f0 + 64; ++f) sacc += pe[f] * w1[(size_t)f * 128 + n];
    ((float*)(p.ws + OFF_C1))[(lk * 32 + ch * 4 + sub) * 128 + n] = sacc;
  }
  if (blockIdx.x == 0) { ((int*)(p.ws + OFF_CTR))[tid] = 0; ((int*)(p.ws + OFF_CTR))[tid + 512] = 0; }
  const int lane = tid & 63, gw = blockIdx.x * 8 + (tid >> 6), nw = G * 8;
  float* ssA = (float*)(p.ws + OFF_SSA);
  bf16_t* xb = (bf16_t*)(p.ws + OFF_XB);
  for (int row = gw; row < NTOK; row += 2 * nw) {
    const int row2 = row + nw;
    f32x4 va[4], vb[4];
#pragma unroll
    for (int i = 0; i < 4; ++i) {
      va[i] = *(const f32x4*)(p.x + (size_t)row * DM + (i * 64 + lane) * 4);
      vb[i] = *(const f32x4*)(p.x + (size_t)(row2 < NTOK ? row2 : row) * DM + (i * 64 + lane) * 4);
    }
    float ssa = 0.f, ssb = 0.f;
#pragma unroll
    for (int i = 0; i < 4; ++i) {
      const size_t offa = (size_t)row * DM + (i * 64 + lane) * 4;
      u32x2 oa = {pk2(va[i][0], va[i][1]), pk2(va[i][2], va[i][3])};
      *(u32x2*)(xb + offa) = oa;
      const f32x4 ra = unpk4(oa);
      ssa += ra[0] * ra[0] + ra[1] * ra[1] + ra[2] * ra[2] + ra[3] * ra[3];
      if (row2 < NTOK) {
        const size_t offb = (size_t)row2 * DM + (i * 64 + lane) * 4;
        u32x2 ob = {pk2(vb[i][0], vb[i][1]), pk2(vb[i][2], vb[i][3])};
        *(u32x2*)(xb + offb) = ob;
        const f32x4 rb = unpk4(ob);
        ssb += rb[0] * rb[0] + rb[1] * rb[1] + rb[2] * rb[2] + rb[3] * rb[3];
      }
    }
#pragma unroll
    for (int o = 32; o > 0; o >>= 1) { ssa += __shfl_xor(ssa, o); ssb += __shfl_xor(ssb, o); }
    if (lane < 8) {
      ssA[(size_t)row * 8 + lane] = (lane == 0) ? ssa : 0.f;
      if (row2 < NTOK) ssA[(size_t)row2 * 8 + lane] = (lane == 0) ? ssb : 0.f;
    }
  }
}

enum { MODE_PROJ = 0, MODE_OUT = 1, MODE_UP = 2, MODE_DOWN = 3 };
typedef __attribute__((address_space(3))) unsigned lds_u32;
constexpr int HT = 128 * 64;

DI int lds_byte(int r, int c) {
  const int st = (r >> 4) * 2 + (c >> 5), rr = r & 15, cc = c & 31, ob = rr * 64 + cc * 2;
  return st * 1024 + (ob ^ (((ob >> 9) & 1) << 5));
}
DI void stage_rc(int b, int& R, int& C) {
  const int st = b / 1024, sb = b % 1024, swz = sb ^ (((sb >> 9) & 1) << 5);
  R = (st >> 1) * 16 + swz / 64; C = (st & 1) * 32 + (swz % 64) / 2;
}

template <int MODE>
DI void gemm_tile(const Params& p, const bf16_t* __restrict__ A, const bf16_t* __restrict__ Bt, int K, int brow, int bcol, int mp, int nt, bool vt, char* smem) {
  bf16_t* shm = (bf16_t*)smem;
  const int tid = my_tid();
  int go0, go1;
  { int r_, c_; stage_rc(tid * 16, r_, c_); go0 = r_ * K + c_; stage_rc(tid * 16 + 8192, r_, c_); go1 = r_ * K + c_; }
#define SA(b, h) (shm + ((b) * 2 + (h)) * HT)
#define SB(b, h) (shm + (4 + (b) * 2 + (h)) * HT)
#define STAGE(P, BASE, br, kt) do { const bf16_t* _gb = (BASE) + (long)(br) * K + (long)(kt) * 64; asm volatile("" : "+s"(_gb)); \
    __builtin_amdgcn_global_load_lds((const unsigned*)(_gb + go0), (lds_u32*)((char*)(P) + tid * 16), 16, 0, 0); \
    __builtin_amdgcn_global_load_lds((const unsigned*)(_gb + go1), (lds_u32*)((char*)(P) + tid * 16 + 8192), 16, 0, 0); } while (0)
#define LDA(dst, b, h) _Pragma("unroll") for (int m = 0; m < 4; ++m) _Pragma("unroll") for (int k = 0; k < 2; ++k) \
    dst[m][k] = *(const __attribute__((address_space(3))) bf16x8*)(aB + (((b) * 2 + (h)) * 16384 + m * 2048 + k * 1024))
#define LDB(dst, b, h) _Pragma("unroll") for (int n = 0; n < 2; ++n) _Pragma("unroll") for (int k = 0; k < 2; ++k) \
    dst[n][k] = *(const __attribute__((address_space(3))) bf16x8*)(bB + (((b) * 2 + (h)) * 16384 + n * 2048 + k * 1024))
#define MMA(ai, bj, At, Bq) do { __builtin_amdgcn_s_setprio(1); \
    _Pragma("unroll") for (int m = 0; m < 4; ++m) _Pragma("unroll") for (int n = 0; n < 2; ++n) _Pragma("unroll") for (int k = 0; k < 2; ++k) \
      acc[ai][bj][m][n] = __builtin_amdgcn_mfma_f32_16x16x32_bf16(At[m][k], Bq[n][k], acc[ai][bj][m][n], 0, 0, 0); \
    __builtin_amdgcn_s_setprio(0); } while (0)
#define WAIT_V(n) asm volatile("s_waitcnt vmcnt(" #n ")" ::: "memory")
#define WAIT_L(n) asm volatile("s_waitcnt lgkmcnt(" #n ")" ::: "memory")
#define BAR __builtin_amdgcn_s_barrier()
#define SCHED __builtin_amdgcn_sched_barrier(0)
  const int wid = tid >> 6, lane = tid & 63, wr = wid >> 2, wc = wid & 3, fr = lane & 15, fq = lane >> 4;
  const int laneoff = (fr * 64 + fq * 16) ^ ((fr >> 3) << 5);
  const __attribute__((address_space(3))) char* aB = (const __attribute__((address_space(3))) char*)smem + wr * 8192 + laneoff;
  const __attribute__((address_space(3))) char* bB = (const __attribute__((address_space(3))) char*)smem + 65536 + wc * 4096 + laneoff;
  f32x4 acc[2][2][4][2];
#pragma unroll
  for (int a = 0; a < 2; ++a)
#pragma unroll
    for (int b = 0; b < 2; ++b)
#pragma unroll
      for (int m = 0; m < 4; ++m)
#pragma unroll
        for (int n = 0; n < 2; ++n) acc[a][b][m][n] = (f32x4){0.f, 0.f, 0.f, 0.f};
  bf16x8 At[4][2], B0[2][2], B1[2][2];
  const int ntk = K / 64;
  const int m0 = mp * 256, n0 = nt * 256;
  float* rsl = (float*)(smem + 131072);
  float4 ssa = make_float4(0.f, 0.f, 0.f, 0.f);
  if (MODE == MODE_PROJ || MODE == MODE_UP)
    ssa = *(const float4*)((const float*)(p.ws + (MODE == MODE_UP ? OFF_SSB : OFF_SSA)) + (size_t)m0 * 8 + tid * 4);
  STAGE(SB(0, 0), Bt, bcol, 0); STAGE(SA(0, 0), A, brow, 0);
  STAGE(SB(0, 1), Bt, bcol + 128, 0); STAGE(SA(0, 1), A, brow + 128, 0);
  if (wr == 1) BAR;
  WAIT_V(4); BAR;
  STAGE(SB(1, 0), Bt, bcol, 1); STAGE(SA(1, 0), A, brow, 1); STAGE(SB(1, 1), Bt, bcol + 128, 1);
  WAIT_V(6); BAR;
  if (MODE == MODE_PROJ || MODE == MODE_UP) {
    float t = (ssa.x + ssa.y) + (ssa.z + ssa.w);
    t += __shfl_xor(t, 1);
    if ((tid & 1) == 0) rsl[tid >> 1] = rsqrtf(t * (1.f / 1024.f) + 1e-6f);
  }
  for (int t = 0; t < ntk - 2; t += 2) {
    LDB(B0, 0, 0); SCHED; LDA(At, 0, 0); STAGE(SA(1, 1), A, brow + 128, t + 1);
    WAIT_L(8); BAR; WAIT_L(0); MMA(0, 0, At, B0); BAR; SCHED;
    LDB(B1, 0, 1); STAGE(SB(0, 0), Bt, bcol, t + 2);
    BAR; WAIT_L(0); MMA(0, 1, At, B1); BAR;
    LDA(At, 0, 1); STAGE(SA(0, 0), A, brow, t + 2);
    BAR; WAIT_L(0); MMA(1, 0, At, B0); BAR; SCHED;
    STAGE(SB(0, 1), Bt, bcol + 128, t + 2);
    WAIT_V(6); BAR; MMA(1, 1, At, B1); BAR;
    LDB(B0, 1, 0); SCHED; LDA(At, 1, 0); STAGE(SA(0, 1), A, brow + 128, t + 2);
    WAIT_L(8); BAR; WAIT_L(0); MMA(0, 0, At, B0); BAR; SCHED;
    LDB(B1, 1, 1); STAGE(SB(1, 0), Bt, bcol, t + 3);
    BAR; WAIT_L(0); MMA(0, 1, At, B1); BAR;
    LDA(At, 1, 1); STAGE(SA(1, 0), A, brow, t + 3);
    BAR; WAIT_L(0); MMA(1, 0, At, B0); BAR; SCHED;
    STAGE(SB(1, 1), Bt, bcol + 128, t + 3);
    WAIT_V(6); BAR; MMA(1, 1, At, B1); BAR;
  }
  { LDB(B0, 0, 0); LDA(At, 0, 0); STAGE(SA(1, 1), A, brow + 128, ntk - 1);
    BAR; WAIT_L(0); MMA(0, 0, At, B0); BAR;
    LDB(B1, 0, 1); BAR; WAIT_L(0); MMA(0, 1, At, B1); BAR;
    LDA(At, 0, 1); WAIT_V(4); BAR; WAIT_L(0); MMA(1, 0, At, B0); MMA(1, 1, At, B1); BAR; }
  { LDB(B0, 1, 0); LDA(At, 1, 0); WAIT_V(2); BAR; WAIT_L(0); MMA(0, 0, At, B0); BAR;
    LDB(B1, 1, 1); WAIT_V(0); BAR; WAIT_L(0); MMA(0, 1, At, B1); BAR;
    LDA(At, 1, 1); BAR; WAIT_L(0); MMA(1, 0, At, B0); MMA(1, 1, At, B1); BAR; }
  if (wr == 0) BAR;
#undef SA
#undef SB
#undef STAGE
#undef LDA
#undef LDB
#undef MMA
  __syncthreads();
  float* st = (float*)smem;
  constexpr bool RESID = (MODE == MODE_OUT || MODE == MODE_DOWN);
  u32x2 xnx[4];
  if (RESID) {
#pragma unroll
    for (int pq = 0; pq < 4; ++pq) xnx[pq] = *(const u32x2*)((const bf16_t*)(p.ws + OFF_XB) + (size_t)(m0 + pq * 16 + (tid >> 5)) * DM + n0 + (tid & 31) * 4);
  }
#pragma unroll
  for (int ai = 0; ai < 2; ++ai)
#pragma unroll
    for (int bj = 0; bj < 2; ++bj) {
#pragma unroll
      for (int m = 0; m < 4; ++m)
#pragma unroll
        for (int n = 0; n < 2; ++n) *(f32x4*)(st + (wc * 32 + n * 16 + fr) * 132 + wr * 64 + m * 16 + fq * 4) = acc[ai][bj][m][n];
      __syncthreads();
#pragma unroll 1
      for (int pg = 0; pg < 2; ++pg) {
      u32x2 xo[4];
      if (RESID) {
#pragma unroll
        for (int pq = 0; pq < 4; ++pq) xo[pq] = xnx[pq];
        const int q = ai * 2 + bj, nq = pg ? q + 1 : q, npg = pg ^ 1;
        if (nq < 4) {
          const int nai = nq >> 1, nbj = nq & 1;
#pragma unroll
          for (int pq = 0; pq < 4; ++pq)
            xnx[pq] = *(const u32x2*)((const bf16_t*)(p.ws + OFF_XB) + (size_t)(m0 + nbj * 128 + (npg * 4 + pq) * 16 + (tid >> 5)) * DM + n0 + nai * 128 + (tid & 31) * 4);
        }
      }
#pragma unroll
      for (int pq = 0; pq < 4; ++pq) {
        const int pass = pg * 4 + pq;
        const int y = pass * 16 + (tid >> 5), x4 = (tid & 31) * 4;
        const f32x4 v = *(const f32x4*)(st + y * 132 + x4);
        if (MODE == MODE_PROJ) {
          if (vt) {
            const int vrow = (nt - 8) * 256 + bj * 128 + y, tk = m0 + ai * 128 + x4, b = tk >> 11, sq = tk & 2047;
            const f32x4 rr = *(const f32x4*)(rsl + ai * 128 + x4);
            u32x2 o = {pk2(v[0] * rr[0], v[1] * rr[1]), pk2(v[2] * rr[2], v[3] * rr[3])};
            *(u32x2*)((bf16_t*)(p.ws + OFF_VT) + ((size_t)(b * VROWS + vrow)) * SEQ + sq) = o;
          } else {
            const int tok = m0 + bj * 128 + y, col = n0 + ai * 128 + x4;
            const float rs = rsl[bj * 128 + y];
            if (col < QKW) {
              u32x2 o = {pk2(v[0] * rs, v[1] * rs), pk2(v[2] * rs, v[3] * rs)};
              *(u32x2*)((bf16_t*)(p.ws + OFF_QK) + (size_t)tok * QKW + col) = o;
            } else if (col < QKW + 16) {
              f32x4 o = {v[0] * rs, v[1] * rs, v[2] * rs, v[3] * rs};
              *(f32x4*)((float*)(p.ws + OFF_GATE) + (size_t)tok * 16 + (col - QKW)) = o;
            }
          }
        } else if (MODE == MODE_UP) {
          const int tok = m0 + bj * 128 + y, col = n0 + ai * 128 + x4;
          const float rs = rsl[bj * 128 + y];
          const float a0 = fmaxf(v[0] * rs, 0.f), a1 = fmaxf(v[1] * rs, 0.f), a2 = fmaxf(v[2] * rs, 0.f), a3 = fmaxf(v[3] * rs, 0.f);
          u32x2 o = {pk2(a0 * a0, a1 * a1), pk2(a2 * a2, a3 * a3)};
          *(u32x2*)((bf16_t*)(p.ws + OFF_U) + (size_t)tok * DFF + col) = o;
        } else {
          const int tok = m0 + bj * 128 + y, col = n0 + ai * 128 + x4;
          const f32x4 xs = unpk4(xo[pq]) + v;
          u32x2 o = {pk2(xs[0], xs[1]), pk2(xs[2], xs[3])};
          *(u32x2*)((bf16_t*)(p.ws + OFF_XB) + (size_t)tok * DM + col) = o;
          const f32x4 xn = unpk4(o);
          float ss = xn[0] * xn[0] + xn[1] * xn[1] + xn[2] * xn[2] + xn[3] * xn[3];
#pragma unroll
          for (int o2 = 16; o2 > 0; o2 >>= 1) ss += __shfl_xor(ss, o2);
          if ((tid & 31) == 0) ((float*)(p.ws + (MODE == MODE_OUT ? OFF_SSB : OFF_SSA)))[(size_t)tok * 8 + nt * 2 + ai] = ss;
        }
      }
      }
      __syncthreads();
    }
}

template <int MODE>
DI void phase_gemm(const Params& p, int l, char* smem) {
  const bf16_t* A; const bf16_t* W; int K, NT;
  if (MODE == MODE_PROJ) { A = (const bf16_t*)(p.ws + OFF_XB); W = (const bf16_t*)(p.ws + OFF_WIN) + (size_t)l * NPROJ * DM; K = DM; NT = 11; }
  else if (MODE == MODE_OUT) { A = (const bf16_t*)(p.ws + OFF_MIX); W = (const bf16_t*)(p.ws + OFF_WOUT) + (size_t)l * DM * DM; K = DM; NT = 4; }
  else if (MODE == MODE_UP) { A = (const bf16_t*)(p.ws + OFF_XB); W = (const bf16_t*)(p.ws + OFF_WUP) + (size_t)l * DFF * DM; K = DM; NT = 16; }
  else { A = (const bf16_t*)(p.ws + OFF_U); W = (const bf16_t*)(p.ws + OFF_WDN) + (size_t)l * DM * DFF; K = DFF; NT = 4; }
  const int G = gridDim.x;
  const bool xmap = (G & 7) == 0;
  const int xcd = blockIdx.x & 7, nb = xmap ? (G >> 3) : G, tot = xmap ? 32 * NT : 256 * NT;
  for (int L = xmap ? (int)(blockIdx.x >> 3) : (int)blockIdx.x; L < tot; L += nb) {
    int mp = (xmap ? xcd * 32 : 0) + L / NT, nt = L % NT;
    if (MODE == MODE_PROJ && xmap && nb == 32) {
      const int g = L / 88, t = L % 88;
      mp = xcd * 32 + g * 8 + (t & 7); nt = t >> 3;
    }
    if (MODE == MODE_UP && xmap && nb == 32) {
      const int it = L >> 5, j = L & 31;
      mp = xcd * 32 + (3 - (it >> 2)) * 8 + (j >> 2); nt = (it & 3) * 4 + (j & 3);
    }
    const bool vt = (MODE == MODE_PROJ) && (nt >= 8);
    gemm_tile<MODE>(p, vt ? A : W, vt ? W : A, K, vt ? mp * 256 : nt * 256, vt ? nt * 256 : mp * 256, mp, nt, vt, smem);
  }
}

DI float gelu_tanh(float x) {
  const float u = 0.7978845608028654f * (x + 0.044715f * x * x * x);
  const float e = __expf(2.f * u);
  const float t = 1.f - 2.f / (e + 1.f);
  return 0.5f * x * (1.f + t);
}

DI void phase_cmp(const Params& p, int l, char* smem) {
  const int tid = my_tid(), lane = tid & 63, w = (tid >> 6) & 3, kh = tid >> 8, r = lane & 31, h = lane >> 5;
  const bf16_t* QK = (const bf16_t*)(p.ws + OFF_QK);
  bf16_t* hid = (bf16_t*)smem;
  float* part = (float*)(smem + 16384);
  for (int u = blockIdx.x; u < 256; u += gridDim.x) {
    const int b = u >> 3, rt = (u >> 1) & 3, kv = u & 1, lk = l * 2 + kv;
    const int blk = min(rt * 32 + r, 126);
    const bf16_t* ap = QK + ((size_t)b * SEQ + 16 * blk) * QKW + (kv ? 832 : 768) + 8 * h;
    const bf16_t* bp = (const bf16_t*)(p.ws + OFF_W1T) + ((size_t)lk * 128 + 32 * w + r) * 2048 + 8 * h;
    f32x16 acc = zero16();
#pragma unroll 16
    for (int ks = kh * 64; ks < kh * 64 + 64; ++ks) {
      const bf16x8 a = *(const bf16x8*)(ap + (size_t)(ks >> 2) * QKW + (ks & 3) * 16);
      const bf16x8 bb = *(const bf16x8*)(bp + ks * 16);
      acc = MFMA(a, bb, acc);
    }
    if (kh == 1) {
#pragma unroll
      for (int i = 0; i < 16; ++i) part[i * 256 + (tid & 255)] = acc[i];
    }
    __syncthreads();
    if (kh == 0) {
      float c1 = 0.f;
#pragma unroll 8
      for (int q = 0; q < 32; ++q) c1 += ((const float*)(p.ws + OFF_C1))[(lk * 32 + q) * 128 + 32 * w + r];
#pragma unroll
      for (int i = 0; i < 16; ++i) {
        const int m = (i & 3) + 8 * (i >> 2) + 4 * h;
        hid[m * 136 + 32 * w + r] = f2bf(gelu_tanh(acc[i] + part[i * 256 + tid] + c1));
      }
    }
    __syncthreads();
    if (kh == 0 && w < 2) {
      const bf16_t* w2 = (const bf16_t*)(p.ws + OFF_W2T) + ((size_t)lk * 64 + 32 * w + r) * 128 + 8 * h;
      f32x16 a2 = zero16();
#pragma unroll
      for (int ks = 0; ks < 8; ++ks) {
        const bf16x8 a = *(const bf16x8*)(hid + r * 136 + ks * 16 + 8 * h);
        const bf16x8 bb = *(const bf16x8*)(w2 + ks * 16);
        a2 = MFMA(a, bb, a2);
      }
      if (kv == 0) {
        bf16_t* kc = (bf16_t*)(p.ws + OFF_KCMP) + (size_t)b * 128 * 64;
#pragma unroll
        for (int i = 0; i < 16; ++i) { const int m = (i & 3) + 8 * (i >> 2) + 4 * h; kc[(rt * 32 + m) * 64 + 32 * w + r] = f2bf(a2[i]); }
      } else {
        bf16_t* vc = (bf16_t*)(p.ws + OFF_VCMP) + (size_t)b * 64 * 128;
#pragma unroll
        for (int g = 0; g < 4; ++g) {
          u32x2 o = {pk2(a2[4 * g], a2[4 * g + 1]), pk2(a2[4 * g + 2], a2[4 * g + 3])};
          *(u32x2*)(vc + (32 * w + r) * 128 + rt * 32 + 8 * g + 4 * h) = o;
        }
      }
    }
    __syncthreads();
  }
}

struct FS { float m, l; f32x16 o0, o1; };
DI void fs_init(FS& s) { s.m = -1e30f; s.l = 0.f; s.o0 = zero16(); s.o1 = zero16(); }

template <int DQK>
DI void load_kv(bf16x8 (&kf)[DQK / 16], s16x4 (&va)[2][4], const bf16_t* __restrict__ Kp, int ldk, const bf16_t* __restrict__ Vt, int ldv, int kt, int r, int h) {
  const int key0 = kt * 32;
  const bf16_t* kp = Kp + (size_t)(key0 + r) * ldk + 8 * h;
#pragma unroll
  for (int ks = 0; ks < DQK / 16; ++ks) kf[ks] = *(const bf16x8*)(kp + 16 * ks);
  const bf16_t* v0p = Vt + (size_t)r * ldv + key0 + 4 * h;
  const bf16_t* v1p = v0p + (size_t)32 * ldv;
#pragma unroll
  for (int q4 = 0; q4 < 4; ++q4) { va[0][q4] = *(const s16x4*)(v0p + 8 * q4); va[1][q4] = *(const s16x4*)(v1p + 8 * q4); }
}

DI void make_cs2(f32x2 (&cs2)[8], float slope2, int kmul) {
#pragma unroll
  for (int j = 0; j < 8; ++j) {
    const int i0 = 2 * j, i1 = 2 * j + 1;
    cs2[j] = (f32x2){slope2 * (float)(kmul * ((i0 & 3) + 8 * (i0 >> 2))), slope2 * (float)(kmul * ((i1 & 3) + 8 * (i1 >> 2)))};
  }
}

struct PendPV { bf16x8 p0, p1, v00, v01, v10, v11; bool on; };
DI void pv_flush(FS& st, PendPV& pd) {
  if (pd.on) {
    st.o0 = MFMA(pd.v00, pd.p0, st.o0); st.o0 = MFMA(pd.v01, pd.p1, st.o0);
    st.o1 = MFMA(pd.v10, pd.p0, st.o1); st.o1 = MFMA(pd.v11, pd.p1, st.o1);
    pd.on = false;
  }
}

template <int DQK, int KMUL>
DI void flash_tile_math(FS& st, const bf16x8* qf, const bf16x8 (&kf)[DQK / 16], const s16x4 (&va)[2][4], int kt, int q0, int qpos, int kadd, unsigned window,
                        float scale2, float slope2, const f32x2 (&cs2)[8], unsigned selmask, bool use_sel, int h, PendPV& pd) {
  const int key0 = kt * 32;
  f32x16 s;
  if (DQK == 64) {
    f32x16 sa = MFMA(kf[0], qf[0], zero16()), sb = MFMA(kf[DQK / 16 - 2], qf[DQK / 16 - 2], zero16());
    sa = MFMA(kf[1], qf[1], sa); sb = MFMA(kf[DQK / 16 - 1], qf[DQK / 16 - 1], sb);
    pv_flush(st, pd);
    s = sa + sb;
  } else {
    s = zero16();
#pragma unroll
    for (int ks = 0; ks < DQK / 16; ++ks) s = MFMA(kf[ks], qf[ks], s);
    pv_flush(st, pd);
  }
  const int dbase = qpos - kadd - KMUL * (key0 + 4 * h);
  const float zb = -slope2 * (float)dbase;
  const bool lsel = use_sel ? (((selmask >> (kt >> 1)) & 1u) != 0u) : true;
  bool need_mask = (KMUL != 1) || (key0 + 31 > q0) || ((unsigned)(q0 + 31 - key0) >= window);
  if (use_sel) need_mask = need_mask || (__ballot(lsel) != ~0ull);
  bf16x8 p0, p1;
  if (need_mask) {
    float z[16];
    float tmax = -1e30f;
#pragma unroll
    for (int i = 0; i < 16; ++i) {
      const int c = (i & 3) + 8 * (i >> 2);
      const int dist = dbase - KMUL * c;
      const bool ok = ((unsigned)dist < window) && lsel;
      float zi = fmaf(s[i], scale2, zb + slope2 * (float)(KMUL * c));
      zi = ok ? zi : -1e30f;
      z[i] = zi; tmax = fmaxf(tmax, zi);
    }
    tmax = fmaxf(tmax, __shfl_xor(tmax, 32));
    const float mn = fmaxf(st.m, tmax);
    const float alpha = ex2(st.m - mn);
    st.m = mn;
    float pv[16]; float ps = 0.f;
#pragma unroll
    for (int i = 0; i < 16; ++i) { float pi = ex2(z[i] - mn); pi = (z[i] > -1e29f) ? pi : 0.f; pv[i] = pi; ps += pi; }
    st.l = st.l * alpha + ps;
    st.o0 *= alpha; st.o1 *= alpha;
    p0 = pack8(pv[0], pv[1], pv[2], pv[3], pv[4], pv[5], pv[6], pv[7]);
    p1 = pack8(pv[8], pv[9], pv[10], pv[11], pv[12], pv[13], pv[14], pv[15]);
  } else {
    f32x2 u2[8];
    float tmax = -3e38f;
#pragma unroll
    for (int j = 0; j < 8; ++j) {
      const f32x2 sv = {s[2 * j], s[2 * j + 1]};
      u2[j] = sv * scale2 + cs2[j];
      tmax = fmaxf(fmaxf(u2[j][0], u2[j][1]), tmax);
    }
    tmax += zb;
    tmax = fmaxf(tmax, __shfl_xor(tmax, 32));
    if (__ballot(tmax > st.m) != 0ull) {
      const float mn = fmaxf(st.m, tmax);
      const float alpha = ex2(st.m - mn);
      st.m = mn; st.l *= alpha; st.o0 *= alpha; st.o1 *= alpha;
    }
    const float d = st.m - zb;
    f32x2 ps2 = {0.f, 0.f};
    unsigned pk[8];
#pragma unroll
    for (int j = 0; j < 8; ++j) {
      const f32x2 e = u2[j] - d;
      const f32x2 pp = {ex2(e[0]), ex2(e[1])};
      ps2 += pp;
      pk[j] = pk2(pp[0], pp[1]);
    }
    st.l += ps2[0] + ps2[1];
    p0 = __builtin_bit_cast(bf16x8, (u32x4){pk[0], pk[1], pk[2], pk[3]});
    p1 = __builtin_bit_cast(bf16x8, (u32x4){pk[4], pk[5], pk[6], pk[7]});
  }
  pd.p0 = p0; pd.p1 = p1;
  pd.v00 = cat8(va[0][0], va[0][1]); pd.v01 = cat8(va[0][2], va[0][3]); pd.v10 = cat8(va[1][0], va[1][1]); pd.v11 = cat8(va[1][2], va[1][3]);
  pd.on = true;
}

template <int DQK, int KMUL>
DI void flash_direct(FS& st, const bf16x8* qf, const bf16_t* __restrict__ Kp, int ldk, const bf16_t* __restrict__ Vt, int ldv, int kt_lo, int kt_hi,
                     int q0, int qpos, int kadd, unsigned window, float scale2, float slope2, int r, int h) {
  f32x2 cs2[8];
  make_cs2(cs2, slope2, KMUL);
  PendPV pd; pd.on = false;
  for (int kt = kt_hi; kt >= kt_lo; --kt) {
    bf16x8 kf[DQK / 16]; s16x4 va[2][4];
    load_kv<DQK>(kf, va, Kp, ldk, Vt, ldv, kt, r, h);
    flash_tile_math<DQK, KMUL>(st, qf, kf, va, kt, q0, qpos, kadd, window, scale2, slope2, cs2, 0u, false, h, pd);
  }
  pv_flush(st, pd);
}

template <int DQK, int NKV> struct StageCfg {
  static constexpr int KCH = 32 * DQK / 8, CS = KCH + 256, NCH = NKV * CS / 512, KST = DQK * 2 + 16, SS = 32 * KST + 64 * 80, BUFSZ = NKV * SS;
};
template <int DQK, int NKV, int NCHX>
DI void stage_load(u32x4 (&reg)[NCHX], const bf16_t* __restrict__ K, int ldk, int kstr, const bf16_t* __restrict__ V, int ldv, int vstr, int kt, int tid) {
  typedef StageCfg<DQK, NKV> C;
#pragma unroll
  for (int i = 0; i < C::NCH; ++i) {
    const int c = tid + 512 * i, sx = c / C::CS, wi = c % C::CS;
    const bf16_t* g;
    if (wi < C::KCH) { const int row = wi / (DQK / 8), ch = wi % (DQK / 8); g = K + (size_t)sx * kstr + (size_t)(kt * 32 + row) * ldk + ch * 8; }
    else { const int w2 = wi - C::KCH, row = w2 >> 2, ch = w2 & 3; g = V + (size_t)sx * vstr + (size_t)row * ldv + kt * 32 + ch * 8; }
    reg[i] = *(const u32x4*)g;
  }
}
template <int DQK, int NKV, int NCHX>
DI void stage_store(const u32x4 (&reg)[NCHX], char* buf, int tid) {
  typedef StageCfg<DQK, NKV> C;
#pragma unroll
  for (int i = 0; i < C::NCH; ++i) {
    const int c = tid + 512 * i, sx = c / C::CS, wi = c % C::CS;
    int off;
    if (wi < C::KCH) { const int row = wi / (DQK / 8), ch = wi % (DQK / 8); off = row * C::KST + ch * 16; }
    else { const int w2 = wi - C::KCH, row = w2 >> 2, ch = w2 & 3; off = 32 * C::KST + row * 80 + ch * 16; }
    *(u32x4*)(buf + sx * C::SS + off) = reg[i];
  }
}
template <int DQK>
DI void lds_kv(bf16x8 (&kf)[DQK / 16], s16x4 (&va)[2][4], const char* sb, int r, int h) {
  constexpr int KST = DQK * 2 + 16;
#pragma unroll
  for (int ks = 0; ks < DQK / 16; ++ks) kf[ks] = *(const bf16x8*)(sb + r * KST + (16 * ks + 8 * h) * 2);
  const char* vb = sb + 32 * KST + r * 80 + 8 * h;
#pragma unroll
  for (int q4 = 0; q4 < 4; ++q4) { va[0][q4] = *(const s16x4*)(vb + 16 * q4); va[1][q4] = *(const s16x4*)(vb + 32 * 80 + 16 * q4); }
}

DI unsigned wave_or32(unsigned v) {
  unsigned u = 0u;
  for (int j = 0; j < 32; ++j) if (__ballot(((v >> j) & 1u) != 0u) != 0ull) u |= 1u << j;
  return u;
}

template <int DQK, int NKV>
DI void flash_block(FS& st, const bf16x8* qf, int sidx, const bf16_t* __restrict__ K, int ldk, int kstr, const bf16_t* __restrict__ V, int ldv, int vstr,
                    int blk_lo, int blk_hi, int my_lo, int my_hi, int q0, int qpos, unsigned window, float scale2, float slope2,
                    unsigned selmask, bool use_sel, char* tbuf, unsigned* bum, int tid, int r, int h) {
  typedef StageCfg<DQK, NKV> C;
  unsigned umask = 0xffffffffu, bmask = 0xffffffffu;
  if (use_sel) {
    umask = wave_or32(selmask);
    if (tid == 0) *bum = 0u;
    __syncthreads();
    if ((tid & 63) == 0) atomicOr(bum, umask);
    __syncthreads();
    bmask = *bum;
  }
  f32x2 cs2[8];
  make_cs2(cs2, slope2, 1);
  PendPV pd; pd.on = false;
  int kt = blk_hi;
  if (use_sel) while (kt >= blk_lo && !((bmask >> (kt >> 1)) & 1u)) --kt;
  if (kt < blk_lo) return;
  int kt1 = kt - 1;
  if (use_sel) while (kt1 >= blk_lo && !((bmask >> (kt1 >> 1)) & 1u)) --kt1;
  u32x4 rg0[C::NCH], rg1[C::NCH];
  stage_load<DQK, NKV>(rg0, K, ldk, kstr, V, ldv, vstr, kt, tid);
  stage_load<DQK, NKV>(rg1, K, ldk, kstr, V, ldv, vstr, kt1 > blk_lo ? kt1 : blk_lo, tid);
  stage_store<DQK, NKV>(rg0, tbuf, tid);
  __syncthreads();
#define FB_ROUND(RA, RB, BUFC, BUFN) { \
    int kt2 = kt1 - 1; \
    if (use_sel) while (kt2 >= blk_lo && !((bmask >> (kt2 >> 1)) & 1u)) --kt2; \
    stage_load<DQK, NKV>(RA, K, ldk, kstr, V, ldv, vstr, kt2 > blk_lo ? kt2 : blk_lo, tid);     \
    if (kt >= my_lo && kt <= my_hi && ((umask >> (kt >> 1)) & 1u)) { \
      bf16x8 kf[DQK / 16]; s16x4 va[2][4]; \
      lds_kv<DQK>(kf, va, tbuf + (BUFC) * C::BUFSZ + sidx * C::SS, r, h); \
      flash_tile_math<DQK, 1>(st, qf, kf, va, kt, q0, qpos, 0, window, scale2, slope2, cs2, selmask, use_sel, h, pd); \
    } \
    if (kt1 >= blk_lo) stage_store<DQK, NKV>(RB, tbuf + (BUFN) * C::BUFSZ, tid); \
    asm volatile("s_waitcnt lgkmcnt(0)" ::: "memory"); __builtin_amdgcn_s_barrier(); asm volatile("" ::: "memory");   \
    kt = kt1; kt1 = kt2; }
  for (;;) {
    FB_ROUND(rg0, rg1, 0, 1);
    if (kt < blk_lo) break;
    FB_ROUND(rg1, rg0, 1, 0);
    if (kt < blk_lo) break;
  }
#undef FB_ROUND
  pv_flush(st, pd);
}

DI void sb_tile_math(f32x16& o0, f32x16& o1, float& R, const bf16x8* qf, const bf16x8 (&kf)[4], const s16x4 (&va)[2][4], int kt, int qpos, int h) {
  const int key0 = kt * 32;
  f32x16 s = zero16();
#pragma unroll
  for (int ks = 0; ks < 4; ++ks) s = MFMA(kf[ks], qf[ks], s);
  const int kb = key0 + 4 * h;
  float beta[16], om[16];
#pragma unroll
  for (int i = 0; i < 16; ++i) {
    const int c = (i & 3) + 8 * (i >> 2);
    const float zz = s[i] * 0.125f;
    const float e = ex2(-fabsf(zz) * LOG2E);
    const float rr = __builtin_amdgcn_rcpf(1.f + e);
    const float sm = e * rr;
    const bool pos = zz >= 0.f, ok = (kb + c) < qpos;
    beta[i] = ok ? (pos ? rr : sm) : 0.f;
    om[i] = ok ? (pos ? sm : rr) : 1.f;
  }
  float G[4], Go[4], T[4];
#pragma unroll
  for (int g = 0; g < 4; ++g) { G[g] = (om[4 * g] * om[4 * g + 1]) * (om[4 * g + 2] * om[4 * g + 3]); Go[g] = __shfl_xor(G[g], 32); T[g] = G[g] * Go[g]; }
  float after[4];
  after[3] = 1.f; after[2] = T[3]; after[1] = T[3] * T[2]; after[0] = after[1] * T[1];
  const float total = after[0] * T[0];
  float a[16];
#pragma unroll
  for (int g = 0; g < 4; ++g) {
    const float ag = (h == 0 ? Go[g] : 1.f) * after[g] * R;
    float t = ag;
    a[4 * g + 3] = beta[4 * g + 3] * t; t *= om[4 * g + 3];
    a[4 * g + 2] = beta[4 * g + 2] * t; t *= om[4 * g + 2];
    a[4 * g + 1] = beta[4 * g + 1] * t; t *= om[4 * g + 1];
    a[4 * g] = beta[4 * g] * t;
  }
  R *= total;
  const bf16x8 p0 = pack8(a[0], a[1], a[2], a[3], a[4], a[5], a[6], a[7]);
  const bf16x8 p1 = pack8(a[8], a[9], a[10], a[11], a[12], a[13], a[14], a[15]);
  o0 = MFMA(cat8(va[0][0], va[0][1]), p0, o0); o0 = MFMA(cat8(va[0][2], va[0][3]), p1, o0);
  o1 = MFMA(cat8(va[1][0], va[1][1]), p0, o1); o1 = MFMA(cat8(va[1][2], va[1][3]), p1, o1);
}

DI void sb_block(f32x16& o0, f32x16& o1, const bf16x8* qf, int sidx, const bf16_t* __restrict__ K, int ldk, int kstr, const bf16_t* __restrict__ V, int ldv, int vstr,
                 int blk_hi, int my_hi, int qpos, char* tbuf, int tid, int r, int h) {
  typedef StageCfg<64, 4> C;
  float R = 1.f;
  bool alive = true;
  u32x4 reg[C::NCH];
  int kt = blk_hi;
  stage_load<64, 4>(reg, K, ldk, kstr, V, ldv, vstr, kt, tid);
  stage_store<64, 4>(reg, tbuf, tid);
  __syncthreads();
  int it = 0;
  for (;;) {
    const bool more = kt > 0;
    if (more) stage_load<64, 4>(reg, K, ldk, kstr, V, ldv, vstr, kt - 1, tid);
    if (alive && kt <= my_hi) {
      bf16x8 kf[4]; s16x4 va[2][4];
      lds_kv<64>(kf, va, tbuf + (it & 1) * C::BUFSZ + sidx * C::SS, r, h);
      sb_tile_math(o0, o1, R, qf, kf, va, kt, qpos, h);
      alive = __ballot(R != 0.f) != 0ull;
    }
    if (more) stage_store<64, 4>(reg, tbuf + ((it + 1) & 1) * C::BUFSZ, tid);
    const int any = __syncthreads_or(alive ? 1 : 0);
    if (!more || !any) break;
    --kt; ++it;
  }
  __syncthreads();
}

DI float sigmoidf_(float x) { return 1.f / (1.f + __expf(-x)); }
DI void acc_store(float* accl, const f32x16& a, const f32x16& b, float f) {
#pragma unroll
  for (int i = 0; i < 16; ++i) { accl[i * 512] = a[i] * f; accl[(16 + i) * 512] = b[i] * f; }
}
DI void acc_add(float* accl, const f32x16& a, const f32x16& b, float f) {
#pragma unroll
  for (int i = 0; i < 16; ++i) { accl[i * 512] += a[i] * f; accl[(16 + i) * 512] += b[i] * f; }
}
DI void acc_final(const float* accl, f32x16& o0, f32x16& o1, const f32x16& a, const f32x16& b, float f) {
#pragma unroll
  for (int i = 0; i < 16; ++i) { o0[i] = accl[i * 512] + a[i] * f; o1[i] = accl[(16 + i) * 512] + b[i] * f; }
}

DI void attn_unit(const Params& p, int l, int b, int qtp, int grp, char* smem) {
  const int tid = my_tid(), lane = tid & 63, w = (tid >> 6) & 3, half = tid >> 8, r = lane & 31, h = lane >> 5;
  const int qt = qtp * 2 + half;
  const bf16_t* QK = (const bf16_t*)(p.ws + OFF_QK);
  const bf16_t* VT = (const bf16_t*)(p.ws + OFF_VT) + (size_t)b * VROWS * SEQ;
  const size_t tok0 = (size_t)b * SEQ;
  const int q0 = qt * 32, qpos = q0 + r;
  const bf16_t* qrow = QK + (tok0 + qpos) * QKW + 8 * h;
  const bf16_t* Kb = QK + tok0 * QKW;
  float* imp = (float*)(smem + half * 16896);
  unsigned* selm = (unsigned*)(smem + 33792 + half * 128);
  float* gn = (float*)(smem + 34048 + half * 512);
  float* accl = (float*)(smem + 35328) + tid;
  unsigned* bum = (unsigned*)(smem + 35076);
  char* tbuf = smem + (grp == 2 ? 35328 : 100864);
  const int q0b = qtp * 64, qtb = qtp * 2 + 1;
  const unsigned INFW = 0x7fffffffu;
  f32x16 o0 = zero16(), o1 = zero16();
  bf16x8 qf[4];
  bool group_norm = true;

  if (grp == 0) {
    const float lam_init = 0.8f - 0.6f * __expf(-0.3f * (float)l);
    float d1 = 0.f, d2 = 0.f;
    for (int i = 0; i < 32; ++i) { d1 += p.lq1[l * 32 + i] * p.lk1[l * 32 + i]; d2 += p.lq2[l * 32 + i] * p.lk2[l * 32 + i]; }
    const float lam = __expf(d1) - __expf(d2) + lam_init;
    const float slope2 = ex2(-(2.f / 3.f) * (float)(3 * w + 2)) * LOG2E;
    const float scale2 = 0.17677669529663687f * LOG2E;
#pragma unroll 1
    for (int c = 0; c < 2; ++c) {
      qf[0] = *(const bf16x8*)(qrow + 1024 + w * 64 + c * 32);
      qf[1] = *(const bf16x8*)(qrow + 1024 + w * 64 + c * 32 + 16);
      FS st; fs_init(st);
      flash_block<32, 4>(st, qf, w, Kb + 1280 + c * 32, QKW, 64, VT + (size_t)384 * SEQ, SEQ, 64 * SEQ, 0, qtb, 0, qt, q0, qpos, INFW, scale2, slope2, 0u, false, tbuf, bum, tid, r, h);
      const float lt = st.l + __shfl_xor(st.l, 32);
      if (c == 0) acc_store(accl, st.o0, st.o1, 1.f / lt);
      else acc_add(accl, st.o0, st.o1, -lam / lt);
    }
#pragma unroll
    for (int i = 0; i < 16; ++i) { o0[i] = accl[i * 512]; o1[i] = accl[(16 + i) * 512]; }
    float ss = 0.f;
#pragma unroll
    for (int i = 0; i < 16; ++i) ss += o0[i] * o0[i] + o1[i] * o1[i];
    ss += __shfl_xor(ss, 32);
    const float sc = rsqrtf(ss * (1.f / 64.f) + EPS) * (1.f - lam_init);
    o0 *= sc; o1 *= sc;
    group_norm = false;
  } else if (grp == 1) {
#pragma unroll
    for (int ks = 0; ks < 4; ++ks) qf[ks] = *(const bf16x8*)(qrow + 512 + w * 64 + 16 * ks);
    const float slope2 = ex2(-(2.f / 3.f) * (float)(3 * w + 1)) * LOG2E;
    const float scale2 = 0.125f * LOG2E;
    const float* gp = (const float*)(p.ws + OFF_GATE) + (tok0 + qpos) * 16 + w * 3;
    const float g0 = sigmoidf_(gp[0]), g1 = sigmoidf_(gp[1]), g2 = sigmoidf_(gp[2]);
    const bf16_t* kc = (const bf16_t*)(p.ws + OFF_KCMP) + (size_t)b * 128 * 64;
    const bf16_t* vc = (const bf16_t*)(p.ws + OFF_VCMP) + (size_t)b * 64 * 128;
    const int ktc = min(3, qt >> 4);
    {
      FS st; fs_init(st);
      flash_direct<64, 16>(st, qf, kc, 64, vc, 128, 0, ktc, q0, qpos, 31, INFW, scale2, slope2, r, h);
      const float lt = st.l + __shfl_xor(st.l, 32);
      const float inv = lt > 0.f ? 1.f / lt : 0.f;
      acc_store(accl, st.o0, st.o1, inv * g0);
      float* impw = imp + (w * 32 + r) * 33;
      for (int kt = 0; kt < 4; ++kt) {
        if (kt <= ktc) {
          const int key0 = kt * 32;
          const bf16_t* kp = kc + (size_t)(key0 + r) * 64 + 8 * h;
          f32x16 s = zero16();
#pragma unroll
          for (int ks = 0; ks < 4; ++ks) s = MFMA(*(const bf16x8*)(kp + 16 * ks), qf[ks], s);
          const int dbase = qpos - 31 - 16 * (key0 + 4 * h);
          const float zb = -slope2 * (float)dbase;
#pragma unroll
          for (int g = 0; g < 4; ++g) {
            float sum4 = 0.f;
#pragma unroll
            for (int k = 0; k < 4; ++k) {
              const int c = k + 8 * g;
              const int dist = dbase - 16 * c;
              const float zi = fmaf(s[4 * g + k], scale2, zb + slope2 * (float)(16 * c));
              const float pi = (dist >= 0) ? ex2(zi - st.m) * inv : 0.f;
              sum4 += pi;
            }
            impw[8 * kt + 2 * g + h] = sum4;
          }
        } else {
#pragma unroll
          for (int g = 0; g < 4; ++g) impw[8 * kt + 2 * g + h] = 0.f;
        }
      }
    }
    __syncthreads();
    if ((tid & 255) < 32) {
      const int cur = qt >> 1;
      const float* scp = imp + (tid & 255) * 33;
      float sc[32];
#pragma unroll
      for (int j = 0; j < 32; ++j) {
        const float v = scp[j] + scp[j + 32 * 33] + scp[j + 2 * 32 * 33] + scp[j + 3 * 32 * 33];
        const bool forced = (j == 0) || (j == cur) || (j == cur - 1);
        sc[j] = (j > cur) ? -1e30f : (forced ? 1e9f : v);
      }
      unsigned mask = 0u;
#pragma unroll 1
      for (int n = 0; n < 8; ++n) {
        float best = -INFINITY; int bj = 0;
#pragma unroll
        for (int j = 0; j < 32; ++j) { const bool gt = sc[j] > best; best = gt ? sc[j] : best; bj = gt ? j : bj; }
#pragma unroll
        for (int j = 0; j < 32; ++j) sc[j] = (j == bj) ? -INFINITY : sc[j];
        mask |= 1u << bj;
      }
      selm[tid & 255] = mask;
    }
    __syncthreads();
    const unsigned selmask = selm[r];
    {
      FS st; fs_init(st);
      flash_block<64, 1>(st, qf, 0, Kb + 896, QKW, 0, VT + (size_t)256 * SEQ, SEQ, 0, 0, qtb, 0, qt, q0, qpos, INFW, scale2, slope2, selmask, true, tbuf, bum, tid, r, h);
      const float lt = st.l + __shfl_xor(st.l, 32);
      acc_add(accl, st.o0, st.o1, g1 / lt);
    }
    {
      FS st; fs_init(st);
      const int lo = q0 >= 511 ? ((q0 - 511) >> 5) : 0, lob = q0b >= 511 ? ((q0b - 511) >> 5) : 0;
      flash_block<64, 1>(st, qf, 0, Kb + 960, QKW, 0, VT + (size_t)320 * SEQ, SEQ, 0, lob, qtb, lo, qt, q0, qpos, 512u, scale2, slope2, 0u, false, tbuf, bum, tid, r, h);
      const float lt = st.l + __shfl_xor(st.l, 32);
      acc_final(accl, o0, o1, st.o0, st.o1, g2 / lt);
    }
  } else if (grp == 2) {
#pragma unroll
    for (int ks = 0; ks < 4; ++ks) qf[ks] = *(const bf16x8*)(qrow + w * 64 + 16 * ks);
    sb_block(o0, o1, qf, w, Kb + 256, QKW, 64, VT, SEQ, 64 * SEQ, qtb, qt, qpos, tbuf, tid, r, h);
  } else {
#pragma unroll
    for (int ks = 0; ks < 4; ++ks) qf[ks] = *(const bf16x8*)(qrow + 1536 + w * 64 + 16 * ks);
    const float slope2 = ex2(-(2.f / 3.f) * (float)(3 * w + 3)) * LOG2E;
    const float scale2 = 0.125f * LOG2E;
    FS st; fs_init(st);
    const int lo = q0 >= 127 ? ((q0 - 127) >> 5) : 0, lob = q0b >= 127 ? ((q0b - 127) >> 5) : 0;
    flash_block<64, 2>(st, qf, w >> 1, Kb + 1792, QKW, 64, VT + (size_t)640 * SEQ, SEQ, 64 * SEQ, lob, qtb, lo, qt, q0, qpos, 128u, scale2, slope2, 0u, false, tbuf, bum, tid, r, h);
    float lt = st.l + __shfl_xor(st.l, 32);
    lt += ex2(p.sinks[l * 4 + w] * LOG2E - st.m);
    const float f = 1.f / lt;
    o0 = st.o0 * f; o1 = st.o1 * f;
  }

  if (group_norm) {
    float ss = 0.f;
#pragma unroll
    for (int i = 0; i < 16; ++i) ss += o0[i] * o0[i] + o1[i] * o1[i];
    ss += __shfl_xor(ss, 32);
    if (h == 0) gn[w * 32 + r] = ss;
    __syncthreads();
    const float tot = gn[r] + gn[32 + r] + gn[64 + r] + gn[96 + r];
    const float sc = rsqrtf(tot * (1.f / 256.f) + EPS);
    o0 *= sc; o1 *= sc;
  }
  const int gcol = (grp == 2 ? 0 : grp == 1 ? 256 : grp == 0 ? 512 : 768) + w * 64 + 4 * h;
  bf16_t* mrow = (bf16_t*)(p.ws + OFF_MIX) + (tok0 + qpos) * DM + gcol;
#pragma unroll
  for (int g = 0; g < 4; ++g) {
    u32x2 a = {pk2(o0[4 * g], o0[4 * g + 1]), pk2(o0[4 * g + 2], o0[4 * g + 3])};
    u32x2 c = {pk2(o1[4 * g], o1[4 * g + 1]), pk2(o1[4 * g + 2], o1[4 * g + 3])};
    *(u32x2*)(mrow + 8 * g) = a;
    *(u32x2*)(mrow + 32 + 8 * g) = c;
  }
  __syncthreads();
}

DI void phase_attn(const Params& p, int l, char* smem) {
  int* ctr = (int*)(p.ws + OFF_CTR) + l * 8;
  int* su = (int*)(smem + 35072);
  const int xcd = blockIdx.x & 7;
  int k = 0;
  for (;;) {
    if (my_tid() == 0) {
      int U = -1;
      for (; k < 8; ++k) {
        const int x = (xcd + k) & 7;
        const int v = atomicAdd(ctr + x, 1);
        if (v < 512) { U = x * 512 + v; break; }
      }
      *su = U;
    }
    __syncthreads();
    const int U = *su;
    __syncthreads();
    if (U < 0) break;
    const int x = U >> 9, v = U & 511;
    const int b = x * 4 + 3 - (v >> 7), wq = v & 127;
    attn_unit(p, l, b, 31 - (wq & 31), wq >> 5, smem);
  }
}

DI void phase_final(const Params& p) {
  const float* ssA = (const float*)(p.ws + OFF_SSA);
  const int lane = my_tid() & 63, gw = blockIdx.x * 8 + (my_tid() >> 6), nw = gridDim.x * 8;
  for (int row = gw; row < NTOK; row += nw) {
    const float rs = row_rstd(ssA, row);
#pragma unroll
    for (int i = 0; i < 4; ++i) {
      const int c = (i * 64 + lane) * 4;
      f32x4 v = unpk4(*(const u32x2*)((const bf16_t*)(p.ws + OFF_XB) + (size_t)row * DM + c));
      const f32x4 g = *(const f32x4*)(p.norm_final + c);
      v = v * rs * g;
      *(f32x4*)(p.xw + (size_t)row * DM + c) = v;
    }
  }
}

DI void grid_bar2(unsigned* bar, unsigned epoch, unsigned per_group) {
  __syncthreads();
  if (my_tid() == 0) {
    __threadfence();
    const unsigned x = blockIdx.x & 7u;
    const unsigned prev = __hip_atomic_fetch_add(bar + x * 32, 1u, __ATOMIC_ACQ_REL, __HIP_MEMORY_SCOPE_AGENT);
    if (prev == per_group - 1u) {
      __hip_atomic_store(bar + x * 32, 0u, __ATOMIC_RELAXED, __HIP_MEMORY_SCOPE_AGENT);
      const unsigned pg = __hip_atomic_fetch_add(bar + 256, 1u, __ATOMIC_ACQ_REL, __HIP_MEMORY_SCOPE_AGENT);
      if (pg == 7u) {
        __hip_atomic_store(bar + 256, 0u, __ATOMIC_RELAXED, __HIP_MEMORY_SCOPE_AGENT);
        for (unsigned j = 0; j < 8u; ++j) __hip_atomic_store(bar + (9u + j) * 32, epoch, __ATOMIC_RELEASE, __HIP_MEMORY_SCOPE_AGENT);
      }
    }
    while (__hip_atomic_load(bar + (9u + x) * 32, __ATOMIC_RELAXED, __HIP_MEMORY_SCOPE_AGENT) < epoch) __builtin_amdgcn_s_sleep(1);
    __threadfence();
    asm volatile("s_waitcnt vmcnt(0)" ::: "memory");
  }
  __syncthreads();
}

__global__ void __launch_bounds__(512, 2) mega(Params p) {
  __shared__ __attribute__((aligned(16))) char smem[163328];
  cg::grid_group grid = cg::this_grid();
  for (int ph = p.ph_lo; ph < p.ph_hi; ++ph) {
    if (ph == 0) phase_prep(p, smem);
    else if (ph == 25) phase_final(p);
    else {
      const int l = (ph - 1) / 6, k = (ph - 1) % 6;
      if (k == 0) phase_gemm<MODE_PROJ>(p, l, smem);
      else if (k == 1) phase_cmp(p, l, smem);
      else if (k == 2) phase_attn(p, l, smem);
      else if (k == 3) phase_gemm<MODE_OUT>(p, l, smem);
      else if (k == 4) phase_gemm<MODE_UP>(p, l, smem);
      else phase_gemm<MODE_DOWN>(p, l, smem);
    }
    if (ph + 1 < p.ph_hi) {
      if (ph == p.ph_lo || (gridDim.x & 7u) != 0u) grid.sync();
      else grid_bar2((unsigned*)(p.ws + OFF_CTR + 1024), (unsigned)(ph - p.ph_lo), gridDim.x >> 3);
    }
  }
}

extern "C" void kernel_launch(void* const* d_in, const int* in_sizes, int n_in, void* d_out, int out_size, void* d_ws, size_t ws_size, hipStream_t stream) {
  static int grid_blocks = 0;
  if (!grid_blocks) {
    int dev = 0, cus = 0, per_cu = 0;
    hipGetDevice(&dev);
    hipDeviceGetAttribute(&cus, hipDeviceAttributeMultiprocessorCount, dev);
    hipOccupancyMaxActiveBlocksPerMultiprocessor(&per_cu, mega, 512, 0);
    if (per_cu > 1) per_cu = 1;
    if (per_cu < 1) per_cu = 1;
    grid_blocks = cus * per_cu;
  }
  Params p{};
  const float** f = (const float**)&p;
  for (int i = 0; i < 20; ++i) f[i] = (const float*)d_in[i];
  p.xw = (float*)d_out;
  p.ws = (char*)d_ws;
  p.ph_lo = 0; p.ph_hi = 26;
  void* args[] = {&p};
  hipError_t e = hipLaunchCooperativeKernel((void*)mega, dim3(grid_blocks), dim3(512), args, 0, stream);
  if (e != hipSuccess) fprintf(stderr, "cooperative launch failed: %s (grid %d)\n", hipGetErrorString(e), grid_blocks);
}
```

```cpp
#include <hip/hip_runtime.h>
#include <hip/hip_cooperative_groups.h>
#include <cstdio>
namespace cg = cooperative_groups;

typedef unsigned short bf16_t;
typedef short bf16x8 __attribute__((ext_vector_type(8)));
typedef short s16x4 __attribute__((ext_vector_type(4)));
typedef float f32x16 __attribute__((ext_vector_type(16)));
typedef float f32x4 __attribute__((ext_vector_type(4)));
typedef float f32x2 __attribute__((ext_vector_type(2)));
typedef unsigned u32x4 __attribute__((ext_vector_type(4)));
typedef unsigned u32x2 __attribute__((ext_vector_type(2)));
typedef __bf16 bf2_t __attribute__((ext_vector_type(2)));
#define DI __device__ __forceinline__
#define MFMA(a, b, c) __builtin_amdgcn_mfma_f32_32x32x16_bf16((a), (b), (c), 0, 0, 0)

constexpr int NTOK = 65536, SEQ = 2048, NB = 32, DM = 1024, DFF = 4096, NL = 4;
constexpr int NPROJ = 2816, QKW = 1920, VROWS = 768, INC = 2700;
constexpr float EPS = 1e-6f, LOG2E = 1.4426950408889634f;

constexpr size_t SZ_WIN = (size_t)NL * NPROJ * DM * 2, SZ_WOUT = (size_t)NL * DM * DM * 2, SZ_WUP = (size_t)NL * DFF * DM * 2, SZ_WDN = SZ_WUP;
constexpr size_t SZ_W1T = (size_t)NL * 2 * 128 * 2048 * 2, SZ_W2T = (size_t)NL * 2 * 64 * 128 * 2, SZ_C1 = 8 * 32 * 128 * 4;
constexpr size_t OFF_WIN = 0, OFF_WOUT = OFF_WIN + SZ_WIN, OFF_WUP = OFF_WOUT + SZ_WOUT, OFF_WDN = OFF_WUP + SZ_WUP;
constexpr size_t OFF_W1T = OFF_WDN + SZ_WDN, OFF_W2T = OFF_W1T + SZ_W1T, OFF_C1 = OFF_W2T + SZ_W2T;
constexpr size_t OFF_SSA = OFF_C1 + SZ_C1, OFF_SSB = OFF_SSA + NTOK * 32, OFF_CTR = OFF_SSB + NTOK * 32;
constexpr size_t OFF_XB = OFF_CTR + 4096, OFF_R = OFF_XB + (size_t)NTOK * DM * 2;
constexpr size_t OFF_QK = OFF_R, OFF_VT = OFF_QK + (size_t)NTOK * QKW * 2, OFF_GATE = OFF_VT + (size_t)NB * VROWS * SEQ * 2;
constexpr size_t OFF_KCMP = OFF_GATE + (size_t)NTOK * 16 * 4, OFF_VCMP = OFF_KCMP + (size_t)NB * 128 * 64 * 2, OFF_MIX = OFF_VCMP + (size_t)NB * 64 * 128 * 2;
constexpr size_t OFF_U = OFF_R;

struct Params {
  const float *x, *norm_attn, *w_in, *pe_k, *w1_k, *w2_k, *pe_v, *w1_v, *w2_v, *lq1, *lk1, *lq2, *lk2, *sinks, *g_mix, *w_out, *norm_mlp, *w_up, *w_down, *norm_final;
  float* xw;
  char* ws;
  int ph_lo, ph_hi;
};

DI int my_tid() { int t = threadIdx.x; asm volatile("" : "+v"(t)); return t; }
DI float row_rstd(const float* ss, int tok) {
  const float4 a = *(const float4*)(ss + (size_t)tok * 8), b = *(const float4*)(ss + (size_t)tok * 8 + 4);
  const float t = ((a.x + a.y) + (a.z + a.w)) + ((b.x + b.y) + (b.z + b.w));
  return rsqrtf(t * (1.f / 1024.f) + 1e-6f);
}
DI unsigned pk2(float a, float b) { f32x2 v = {a, b}; bf2_t r = __builtin_convertvector(v, bf2_t); return __builtin_bit_cast(unsigned, r); }
DI f32x4 unpk4(u32x2 u) { f32x4 r = {__uint_as_float(u[0] << 16), __uint_as_float(u[0] & 0xffff0000u), __uint_as_float(u[1] << 16), __uint_as_float(u[1] & 0xffff0000u)}; return r; }
DI bf16_t f2bf(float a) { return (bf16_t)(pk2(a, 0.f) & 0xffffu); }
DI float ex2(float x) { return __builtin_amdgcn_exp2f(x); }
DI bf16x8 cat8(s16x4 lo, s16x4 hi) { return __builtin_shufflevector(lo, hi, 0, 1, 2, 3, 4, 5, 6, 7); }
DI f32x16 zero16() { f32x16 z; _Pragma("unroll") for (int i = 0; i < 16; ++i) z[i] = 0.f; return z; }
DI bf16x8 pack8(float a0, float a1, float a2, float a3, float a4, float a5, float a6, float a7) {
  u32x4 u = {pk2(a0, a1), pk2(a2, a3), pk2(a4, a5), pk2(a6, a7)};
  return __builtin_bit_cast(bf16x8, u);
}

DI void cvt_tile(const float* __restrict__ src, int C, int c0, int valid, bf16_t* __restrict__ dst, int R, int r0, const float* __restrict__ gain, char* smem) {
  float* t = (float*)smem;
  const int tid = my_tid();
  {
    const int col = tid & 63;
    float v[8], g[8];
#pragma unroll
    for (int i = 0; i < 8; ++i) {
      const int row = i * 8 + (tid >> 6);
      v[i] = (col < valid) ? src[(size_t)(r0 + row) * C + c0 + col] : 0.f;
      g[i] = gain ? gain[r0 + row] : 1.f;
    }
#pragma unroll
    for (int i = 0; i < 8; ++i) t[(i * 8 + (tid >> 6)) * 65 + col] = v[i] * g[i];
  }
  __syncthreads();
  {
    const int j = tid >> 3, i8 = (tid & 7) * 8;
    u32x4 o;
    o[0] = pk2(t[(i8 + 0) * 65 + j], t[(i8 + 1) * 65 + j]); o[1] = pk2(t[(i8 + 2) * 65 + j], t[(i8 + 3) * 65 + j]);
    o[2] = pk2(t[(i8 + 4) * 65 + j], t[(i8 + 5) * 65 + j]); o[3] = pk2(t[(i8 + 6) * 65 + j], t[(i8 + 7) * 65 + j]);
    *(u32x4*)(dst + (size_t)j * R + r0 + i8) = o;
  }
  __syncthreads();
}

DI void win_map(int dc, int& c0, int& valid) {
  valid = 64;
  if (dc < 4) c0 = 64 * dc;
  else if (dc < 8) c0 = 256 + 64 * (dc - 4);
  else if (dc < 12) c0 = 768 + 64 * (dc - 8);
  else if (dc == 12) c0 = 1024;
  else if (dc == 13) c0 = 1088;
  else if (dc == 14) c0 = 1152;
  else if (dc == 15) c0 = 1280;
  else if (dc < 20) c0 = 1420 + 64 * (dc - 16);
  else if (dc < 24) c0 = 1676 + 64 * (dc - 20);
  else if (dc < 28) c0 = 2188 + 64 * (dc - 24);
  else if (dc < 30) c0 = 2444 + 64 * (dc - 28);
  else if (dc == 30) { c0 = 1408; valid = 12; }
  else if (dc == 31) { c0 = 0; valid = 0; }
  else if (dc < 36) c0 = 512 + 64 * (dc - 32);
  else if (dc == 36) c0 = 1216;
  else if (dc == 37) c0 = 1344;
  else if (dc < 42) c0 = 1932 + 64 * (dc - 38);
  else c0 = 2572 + 64 * (dc - 42);
}

DI void phase_prep(const Params& p, char* smem) {
  const int tid = my_tid(), G = gridDim.x;
  constexpr int N_WIN = NL * 44 * 16, N_WOUT = NL * 16 * 16, N_WUP = NL * 64 * 16, N_WDN = NL * 16 * 64, N_W1 = NL * 2 * 2 * 32, N_W2 = NL * 2 * 2;
  constexpr int N_ALL = N_WIN + N_WOUT + N_WUP + N_WDN + N_W1 + N_W2;
  for (int t = blockIdx.x; t < N_ALL; t += G) {
    int u = t;
    if (u < N_WIN) {
      const int l = u / 704, v = u % 704, dc = v / 16, rc = v % 16; int c0, valid; win_map(dc, c0, valid);
      cvt_tile(p.w_in + (size_t)l * DM * INC, INC, c0, valid, (bf16_t*)(p.ws + OFF_WIN) + ((size_t)l * NPROJ + dc * 64) * DM, DM, rc * 64, p.norm_attn + l * DM, smem);
      continue;
    }
    u -= N_WIN;
    if (u < N_WOUT) {
      const int l = u / 256, v = u % 256, dc = v / 16, rc = v % 16;
      cvt_tile(p.w_out + (size_t)l * DM * DM, DM, dc * 64, 64, (bf16_t*)(p.ws + OFF_WOUT) + ((size_t)l * DM + dc * 64) * DM, DM, rc * 64, p.g_mix + l * DM, smem);
      continue;
    }
    u -= N_WOUT;
    if (u < N_WUP) {
      const int l = u / 1024, v = u % 1024, dc = v / 16, rc = v % 16;
      cvt_tile(p.w_up + (size_t)l * DM * DFF, DFF, dc * 64, 64, (bf16_t*)(p.ws + OFF_WUP) + ((size_t)l * DFF + dc * 64) * DM, DM, rc * 64, p.norm_mlp + l * DM, smem);
      continue;
    }
    u -= N_WUP;
    if (u < N_WDN) {
      const int l = u / 1024, v = u % 1024, dc = v / 64, rc = v % 64;
      cvt_tile(p.w_down + (size_t)l * DFF * DM, DM, dc * 64, 64, (bf16_t*)(p.ws + OFF_WDN) + ((size_t)l * DM + dc * 64) * DFF, DFF, rc * 64, nullptr, smem);
      continue;
    }
    u -= N_WDN;
    if (u < N_W1) {
      const int lk = u / 64, v = u % 64, dc = v / 32, rc = v % 32, l = lk >> 1, kv = lk & 1;
      const float* src = (kv ? p.w1_v : p.w1_k) + (size_t)l * 2048 * 128;
      cvt_tile(src, 128, dc * 64, 64, (bf16_t*)(p.ws + OFF_W1T) + ((size_t)lk * 128 + dc * 64) * 2048, 2048, rc * 64, nullptr, smem);
      continue;
    }
    u -= N_W1;
    {
      const int lk = u / 2, rc = u % 2, l = lk >> 1, kv = lk & 1;
      const float* src = (kv ? p.w2_v : p.w2_k) + (size_t)l * 128 * 64;
      cvt_tile(src, 64, 0, 64, (bf16_t*)(p.ws + OFF_W2T) + (size_t)lk * 64 * 128, 128, rc * 64, nullptr, smem);
    }
  }
  if (blockIdx.x < 64) {
    const int lk = blockIdx.x >> 3, ch = blockIdx.x & 7, l = lk >> 1, kv = lk & 1, n = tid & 127, sub = tid >> 7;
    const float* pe = (kv ? p.pe_v : p.pe_k) + (size_t)l * 2048;
    const float* w1 = (kv ? p.w1_v : p.w1_k) + (size_t)l * 2048 * 128;
    const int f0 = ch * 256 + sub * 64;
    float sacc = 0.f;
#pragma unroll 16
    for (int f = f0; f < f0 + 64; ++f) sacc += pe[f] * w1[(size_t)f * 128 + n];
    ((float*)(p.ws + OFF_C1))[(lk * 32 + ch * 4 + sub) * 128 + n] = sacc;
  }
  if (blockIdx.x == 0) { ((int*)(p.ws + OFF_CTR))[tid] = 0; ((int*)(p.ws + OFF_CTR))[tid + 512] = 0; }
  const int lane = tid & 63, gw = blockIdx.x * 8 + (tid >> 6), nw = G * 8;
  float* ssA = (float*)(p.ws + OFF_SSA);
  bf16_t* xb = (bf16_t*)(p.ws + OFF_XB);
  for (int row = gw; row < NTOK; row += 2 * nw) {
    const int row2 = row + nw;
    f32x4 va[4], vb[4];
#pragma unroll
    for (int i = 0; i < 4; ++i) {
      va[i] = *(const f32x4*)(p.x + (size_t)row * DM + (i * 64 + lane) * 4);
      vb[i] = *(const f32x4*)(p.x + (size_t)(row2 < NTOK ? row2 : row) * DM + (i * 64 + lane) * 4);
    }
    float ssa = 0.f, ssb = 0.f;
#pragma unroll
    for (int i = 0; i < 4; ++i) {
      const size_t offa = (size_t)row * DM + (i * 64 + lane) * 4;
      u32x2 oa = {pk2(va[i][0], va[i][1]), pk2(va[i][2], va[i][3])};
      *(u32x2*)(xb + offa) = oa;
      const f32x4 ra = unpk4(oa);
      ssa += ra[0] * ra[0] + ra[1] * ra[1] + ra[2] * ra[2] + ra[3] * ra[3];
      if (row2 < NTOK) {
        const size_t offb = (size_t)row2 * DM + (i * 64 + lane) * 4;
        u32x2 ob = {pk2(vb[i][0], vb[i][1]), pk2(vb[i][2], vb[i][3])};
        *(u32x2*)(xb + offb) = ob;
        const f32x4 rb = unpk4(ob);
        ssb += rb[0] * rb[0] + rb[1] * rb[1] + rb[2] * rb[2] + rb[3] * rb[3];
      }
    }
#pragma unroll
    for (int o = 32; o > 0; o >>= 1) { ssa += __shfl_xor(ssa, o); ssb += __shfl_xor(ssb, o); }
    if (lane < 8) {
      ssA[(size_t)row * 8 + lane] = (lane == 0) ? ssa : 0.f;
      if (row2 < NTOK) ssA[(size_t)row2 * 8 + lane] = (lane == 0) ? ssb : 0.f;
    }
  }
}

enum { MODE_PROJ = 0, MODE_OUT = 1, MODE_UP = 2, MODE_DOWN = 3 };
typedef __attribute__((address_space(3))) unsigned lds_u32;
constexpr int HT = 128 * 64;

DI int lds_byte(int r, int c) {
  const int st = (r >> 4) * 2 + (c >> 5), rr = r & 15, cc = c & 31, ob = rr * 64 + cc * 2;
  return st * 1024 + (ob ^ (((ob >> 9) & 1) << 5));
}
DI void stage_rc(int b, int& R, int& C) {
  const int st = b / 1024, sb = b % 1024, swz = sb ^ (((sb >> 9) & 1) << 5);
  R = (st >> 1) * 16 + swz / 64; C = (st & 1) * 32 + (swz % 64) / 2;
}

template <int MODE>
DI void gemm_tile(const Params& p, const bf16_t* __restrict__ A, const bf16_t* __restrict__ Bt, int K, int brow, int bcol, int mp, int nt, bool vt, char* smem) {
  bf16_t* shm = (bf16_t*)smem;
  const int tid = my_tid();
  int go0, go1;
  { int r_, c_; stage_rc(tid * 16, r_, c_); go0 = r_ * K + c_; stage_rc(tid * 16 + 8192, r_, c_); go1 = r_ * K + c_; }
#define SA(b, h) (shm + ((b) * 2 + (h)) * HT)
#define SB(b, h) (shm + (4 + (b) * 2 + (h)) * HT)
#define STAGE(P, BASE, br, kt) do { const bf16_t* _gb = (BASE) + (long)(br) * K + (long)(kt) * 64; asm volatile("" : "+s"(_gb)); \
    __builtin_amdgcn_global_load_lds((const unsigned*)(_gb + go0), (lds_u32*)((char*)(P) + tid * 16), 16, 0, 0); \
    __builtin_amdgcn_global_load_lds((const unsigned*)(_gb + go1), (lds_u32*)((char*)(P) + tid * 16 + 8192), 16, 0, 0); } while (0)
#define LDA(dst, b, h) _Pragma("unroll") for (int m = 0; m < 4; ++m) _Pragma("unroll") for (int k = 0; k < 2; ++k) \
    dst[m][k] = *(const __attribute__((address_space(3))) bf16x8*)(aB + (((b) * 2 + (h)) * 16384 + m * 2048 + k * 1024))
#define LDB(dst, b, h) _Pragma("unroll") for (int n = 0; n < 2; ++n) _Pragma("unroll") for (int k = 0; k < 2; ++k) \
    dst[n][k] = *(const __attribute__((address_space(3))) bf16x8*)(bB + (((b) * 2 + (h)) * 16384 + n * 2048 + k * 1024))
#define MMA(ai, bj, At, Bq) do { __builtin_amdgcn_s_setprio(1); \
    _Pragma("unroll") for (int m = 0; m < 4; ++m) _Pragma("unroll") for (int n = 0; n < 2; ++n) _Pragma("unroll") for (int k = 0; k < 2; ++k) \
      acc[ai][bj][m][n] = __builtin_amdgcn_mfma_f32_16x16x32_bf16(At[m][k], Bq[n][k], acc[ai][bj][m][n], 0, 0, 0); \
    __builtin_amdgcn_s_setprio(0); } while (0)
#define WAIT_V(n) asm volatile("s_waitcnt vmcnt(" #n ")" ::: "memory")
#define WAIT_L(n) asm volatile("s_waitcnt lgkmcnt(" #n ")" ::: "memory")
#define BAR __builtin_amdgcn_s_barrier()
#define SCHED __builtin_amdgcn_sched_barrier(0)
  const int wid = tid >> 6, lane = tid & 63, wr = wid >> 2, wc = wid & 3, fr = lane & 15, fq = lane >> 4;
  const int laneoff = (fr * 64 + fq * 16) ^ ((fr >> 3) << 5);
  const __attribute__((address_space(3))) char* aB = (const __attribute__((address_space(3))) char*)smem + wr * 8192 + laneoff;
  const __attribute__((address_space(3))) char* bB = (const __attribute__((address_space(3))) char*)smem + 65536 + wc * 4096 + laneoff;
  f32x4 acc[2][2][4][2];
#pragma unroll
  for (int a = 0; a < 2; ++a)
#pragma unroll
    for (int b = 0; b < 2; ++b)
#pragma unroll
      for (int m = 0; m < 4; ++m)
#pragma unroll
        for (int n = 0; n < 2; ++n) acc[a][b][m][n] = (f32x4){0.f, 0.f, 0.f, 0.f};
  bf16x8 At[4][2], B0[2][2], B1[2][2];
  const int ntk = K / 64;
  const int m0 = mp * 256, n0 = nt * 256;
  float* rsl = (float*)(smem + 131072);
  float4 ssa = make_float4(0.f, 0.f, 0.f, 0.f);
  if (MODE == MODE_PROJ || MODE == MODE_UP)
    ssa = *(const float4*)((const float*)(p.ws + (MODE == MODE_UP ? OFF_SSB : OFF_SSA)) + (size_t)m0 * 8 + tid * 4);
  STAGE(SB(0, 0), Bt, bcol, 0); STAGE(SA(0, 0), A, brow, 0);
  STAGE(SB(0, 1), Bt, bcol + 128, 0); STAGE(SA(0, 1), A, brow + 128, 0);
  if (wr == 1) BAR;
  WAIT_V(4); BAR;
  STAGE(SB(1, 0), Bt, bcol, 1); STAGE(SA(1, 0), A, brow, 1); STAGE(SB(1, 1), Bt, bcol + 128, 1);
  WAIT_V(6); BAR;
  if (MODE == MODE_PROJ || MODE == MODE_UP) {
    float t = (ssa.x + ssa.y) + (ssa.z + ssa.w);
    t += __shfl_xor(t, 1);
    if ((tid & 1) == 0) rsl[tid >> 1] = rsqrtf(t * (1.f / 1024.f) + 1e-6f);
  }
  for (int t = 0; t < ntk - 2; t += 2) {
    LDB(B0, 0, 0); SCHED; LDA(At, 0, 0); STAGE(SA(1, 1), A, brow + 128, t + 1);
    WAIT_L(8); BAR; WAIT_L(0); MMA(0, 0, At, B0); BAR; SCHED;
    LDB(B1, 0, 1); STAGE(SB(0, 0), Bt, bcol, t + 2);
    BAR; WAIT_L(0); MMA(0, 1, At, B1); BAR;
    LDA(At, 0, 1); STAGE(SA(0, 0), A, brow, t + 2);
    BAR; WAIT_L(0); MMA(1, 0, At, B0); BAR; SCHED;
    STAGE(SB(0, 1), Bt, bcol + 128, t + 2);
    WAIT_V(6); BAR; MMA(1, 1, At, B1); BAR;
    LDB(B0, 1, 0); SCHED; LDA(At, 1, 0); STAGE(SA(0, 1), A, brow + 128, t + 2);
    WAIT_L(8); BAR; WAIT_L(0); MMA(0, 0, At, B0); BAR; SCHED;
    LDB(B1, 1, 1); STAGE(SB(1, 0), Bt, bcol, t + 3);
    BAR; WAIT_L(0); MMA(0, 1, At, B1); BAR;
    LDA(At, 1, 1); STAGE(SA(1, 0), A, brow, t + 3);
    BAR; WAIT_L(0); MMA(1, 0, At, B0); BAR; SCHED;
    STAGE(SB(1, 1), Bt, bcol + 128, t + 3);
    WAIT_V(6); BAR; MMA(1, 1, At, B1); BAR;
  }
  { LDB(B0, 0, 0); LDA(At, 0, 0); STAGE(SA(1, 1), A, brow + 128, ntk - 1);
    BAR; WAIT_L(0); MMA(0, 0, At, B0); BAR;
    LDB(B1, 0, 1); BAR; WAIT_L(0); MMA(0, 1, At, B1); BAR;
    LDA(At, 0, 1); WAIT_V(4); BAR; WAIT_L(0); MMA(1, 0, At, B0); MMA(1, 1, At, B1); BAR; }
  { LDB(B0, 1, 0); LDA(At, 1, 0); WAIT_V(2); BAR; WAIT_L(0); MMA(0, 0, At, B0); BAR;
    LDB(B1, 1, 1); WAIT_V(0); BAR; WAIT_L(0); MMA(0, 1, At, B1); BAR;
    LDA(At, 1, 1); BAR; WAIT_L(0); MMA(1, 0, At, B0); MMA(1, 1, At, B1); BAR; }
  if (wr == 0) BAR;
#undef SA
#undef SB
#undef STAGE
#undef LDA
#undef LDB
#undef MMA
  __syncthreads();
  float* st = (float*)smem;
  constexpr bool RESID = (MODE == MODE_OUT || MODE == MODE_DOWN);
  u32x2 xnx[4];
  if (RESID) {
#pragma unroll
    for (int pq = 0; pq < 4; ++pq) xnx[pq] = *(const u32x2*)((const bf16_t*)(p.ws + OFF_XB) + (size_t)(m0 + pq * 16 + (tid >> 5)) * DM + n0 + (tid & 31) * 4);
  }
#pragma unroll
  for (int ai = 0; ai < 2; ++ai)
#pragma unroll
    for (int bj = 0; bj < 2; ++bj) {
#pragma unroll
      for (int m = 0; m < 4; ++m)
#pragma unroll
        for (int n = 0; n < 2; ++n) *(f32x4*)(st + (wc * 32 + n * 16 + fr) * 132 + wr * 64 + m * 16 + fq * 4) = acc[ai][bj][m][n];
      __syncthreads();
#pragma unroll 1
      for (int pg = 0; pg < 2; ++pg) {
      u32x2 xo[4];
      if (RESID) {
#pragma unroll
        for (int pq = 0; pq < 4; ++pq) xo[pq] = xnx[pq];
        const int q = ai * 2 + bj, nq = pg ? q + 1 : q, npg = pg ^ 1;
        if (nq < 4) {
          const int nai = nq >> 1, nbj = nq & 1;
#pragma unroll
          for (int pq = 0; pq < 4; ++pq)
            xnx[pq] = *(const u32x2*)((const bf16_t*)(p.ws + OFF_XB) + (size_t)(m0 + nbj * 128 + (npg * 4 + pq) * 16 + (tid >> 5)) * DM + n0 + nai * 128 + (tid & 31) * 4);
        }
      }
#pragma unroll
      for (int pq = 0; pq < 4; ++pq) {
        const int pass = pg * 4 + pq;
        const int y = pass * 16 + (tid >> 5), x4 = (tid & 31) * 4;
        const f32x4 v = *(const f32x4*)(st + y * 132 + x4);
        if (MODE == MODE_PROJ) {
          if (vt) {
            const int vrow = (nt - 8) * 256 + bj * 128 + y, tk = m0 + ai * 128 + x4, b = tk >> 11, sq = tk & 2047;
            const f32x4 rr = *(const f32x4*)(rsl + ai * 128 + x4);
            u32x2 o = {pk2(v[0] * rr[0], v[1] * rr[1]), pk2(v[2] * rr[2], v[3] * rr[3])};
            *(u32x2*)((bf16_t*)(p.ws + OFF_VT) + ((size_t)(b * VROWS + vrow)) * SEQ + sq) = o;
          } else {
            const int tok = m0 + bj * 128 + y, col = n0 + ai * 128 + x4;
            const float rs = rsl[bj * 128 + y];
            if (col < QKW) {
              u32x2 o = {pk2(v[0] * rs, v[1] * rs), pk2(v[2] * rs, v[3] * rs)};
              *(u32x2*)((bf16_t*)(p.ws + OFF_QK) + (size_t)tok * QKW + col) = o;
            } else if (col < QKW + 16) {
              f32x4 o = {v[0] * rs, v[1] * rs, v[2] * rs, v[3] * rs};
              *(f32x4*)((float*)(p.ws + OFF_GATE) + (size_t)tok * 16 + (col - QKW)) = o;
            }
          }
        } else if (MODE == MODE_UP) {
          const int tok = m0 + bj * 128 + y, col = n0 + ai * 128 + x4;
          const float rs = rsl[bj * 128 + y];
          const float a0 = fmaxf(v[0] * rs, 0.f), a1 = fmaxf(v[1] * rs, 0.f), a2 = fmaxf(v[2] * rs, 0.f), a3 = fmaxf(v[3] * rs, 0.f);
          u32x2 o = {pk2(a0 * a0, a1 * a1), pk2(a2 * a2, a3 * a3)};
          *(u32x2*)((bf16_t*)(p.ws + OFF_U) + (size_t)tok * DFF + col) = o;
        } else {
          const int tok = m0 + bj * 128 + y, col = n0 + ai * 128 + x4;
          const f32x4 xs = unpk4(xo[pq]) + v;
          u32x2 o = {pk2(xs[0], xs[1]), pk2(xs[2], xs[3])};
          *(u32x2*)((bf16_t*)(p.ws + OFF_XB) + (size_t)tok * DM + col) = o;
          const f32x4 xn = unpk4(o);
          float ss = xn[0] * xn[0] + xn[1] * xn[1] + xn[2] * xn[2] + xn[3] * xn[3];
#pragma unroll
          for (int o2 = 16; o2 > 0; o2 >>= 1) ss += __shfl_xor(ss, o2);
          if ((tid & 31) == 0) ((float*)(p.ws + (MODE == MODE_OUT ? OFF_SSB : OFF_SSA)))[(size_t)tok * 8 + nt * 2 + ai] = ss;
        }
      }
      }
      __syncthreads();
    }
}

template <int MODE>
DI void phase_gemm(const Params& p, int l, char* smem) {
  const bf16_t* A; const bf16_t* W; int K, NT;
  if (MODE == MODE_PROJ) { A = (const bf16_t*)(p.ws + OFF_XB); W = (const bf16_t*)(p.ws + OFF_WIN) + (size_t)l * NPROJ * DM; K = DM; NT = 11; }
  else if (MODE == MODE_OUT) { A = (const bf16_t*)(p.ws + OFF_MIX); W = (const bf16_t*)(p.ws + OFF_WOUT) + (size_t)l * DM * DM; K = DM; NT = 4; }
  else if (MODE == MODE_UP) { A = (const bf16_t*)(p.ws + OFF_XB); W = (const bf16_t*)(p.ws + OFF_WUP) + (size_t)l * DFF * DM; K = DM; NT = 16; }
  else { A = (const bf16_t*)(p.ws + OFF_U); W = (const bf16_t*)(p.ws + OFF_WDN) + (size_t)l * DM * DFF; K = DFF; NT = 4; }
  const int G = gridDim.x;
  const bool xmap = (G & 7) == 0;
  const int xcd = blockIdx.x & 7, nb = xmap ? (G >> 3) : G, tot = xmap ? 32 * NT : 256 * NT;
  for (int L = xmap ? (int)(blockIdx.x >> 3) : (int)blockIdx.x; L < tot; L += nb) {
    int mp = (xmap ? xcd * 32 : 0) + L / NT, nt = L % NT;
    if (MODE == MODE_PROJ && xmap && nb == 32) {
      const int g = L / 88, t = L % 88;
      mp = xcd * 32 + g * 8 + (t & 7); nt = t >> 3;
    }
    if (MODE == MODE_UP && xmap && nb == 32) {
      const int it = L >> 5, j = L & 31;
      mp = xcd * 32 + (3 - (it >> 2)) * 8 + (j >> 2); nt = (it & 3) * 4 + (j & 3);
    }
    const bool vt = (MODE == MODE_PROJ) && (nt >= 8);
    gemm_tile<MODE>(p, vt ? A : W, vt ? W : A, K, vt ? mp * 256 : nt * 256, vt ? nt * 256 : mp * 256, mp, nt, vt, smem);
  }
}

DI float gelu_tanh(float x) {
  const float u = 0.7978845608028654f * (x + 0.044715f * x * x * x);
  const float e = __expf(2.f * u);
  const float t = 1.f - 2.f / (e + 1.f);
  return 0.5f * x * (1.f + t);
}

DI void phase_cmp(const Params& p, int l, char* smem) {
  const int tid = my_tid(), lane = tid & 63, w = (tid >> 6) & 3, kh = tid >> 8, r = lane & 31, h = lane >> 5;
  const bf16_t* QK = (const bf16_t*)(p.ws + OFF_QK);
  bf16_t* hid = (bf16_t*)smem;
  float* part = (float*)(smem + 16384);
  for (int u = blockIdx.x; u < 256; u += gridDim.x) {
    const int b = u >> 3, rt = (u >> 1) & 3, kv = u & 1, lk = l * 2 + kv;
    const int blk = min(rt * 32 + r, 126);
    const bf16_t* ap = QK + ((size_t)b * SEQ + 16 * blk) * QKW + (kv ? 832 : 768) + 8 * h;
    const bf16_t* bp = (const bf16_t*)(p.ws + OFF_W1T) + ((size_t)lk * 128 + 32 * w + r) * 2048 + 8 * h;
    f32x16 acc = zero16();
#pragma unroll 16
    for (int ks = kh * 64; ks < kh * 64 + 64; ++ks) {
      const bf16x8 a = *(const bf16x8*)(ap + (size_t)(ks >> 2) * QKW + (ks & 3) * 16);
      const bf16x8 bb = *(const bf16x8*)(bp + ks * 16);
      acc = MFMA(a, bb, acc);
    }
    if (kh == 1) {
#pragma unroll
      for (int i = 0; i < 16; ++i) part[i * 256 + (tid & 255)] = acc[i];
    }
    __syncthreads();
    if (kh == 0) {
      float c1 = 0.f;
#pragma unroll 8
      for (int q = 0; q < 32; ++q) c1 += ((const float*)(p.ws + OFF_C1))[(lk * 32 + q) * 128 + 32 * w + r];
#pragma unroll
      for (int i = 0; i < 16; ++i) {
        const int m = (i & 3) + 8 * (i >> 2) + 4 * h;
        hid[m * 136 + 32 * w + r] = f2bf(gelu_tanh(acc[i] + part[i * 256 + tid] + c1));
      }
    }
    __syncthreads();
    if (kh == 0 && w < 2) {
      const bf16_t* w2 = (const bf16_t*)(p.ws + OFF_W2T) + ((size_t)lk * 64 + 32 * w + r) * 128 + 8 * h;
      f32x16 a2 = zero16();
#pragma unroll
      for (int ks = 0; ks < 8; ++ks) {
        const bf16x8 a = *(const bf16x8*)(hid + r * 136 + ks * 16 + 8 * h);
        const bf16x8 bb = *(const bf16x8*)(w2 + ks * 16);
        a2 = MFMA(a, bb, a2);
      }
      if (kv == 0) {
        bf16_t* kc = (bf16_t*)(p.ws + OFF_KCMP) + (size_t)b * 128 * 64;
#pragma unroll
        for (int i = 0; i < 16; ++i) { const int m = (i & 3) + 8 * (i >> 2) + 4 * h; kc[(rt * 32 + m) * 64 + 32 * w + r] = f2bf(a2[i]); }
      } else {
        bf16_t* vc = (bf16_t*)(p.ws + OFF_VCMP) + (size_t)b * 64 * 128;
#pragma unroll
        for (int g = 0; g < 4; ++g) {
          u32x2 o = {pk2(a2[4 * g], a2[4 * g + 1]), pk2(a2[4 * g + 2], a2[4 * g + 3])};
          *(u32x2*)(vc + (32 * w + r) * 128 + rt * 32 + 8 * g + 4 * h) = o;
        }
      }
    }
    __syncthreads();
  }
}

struct FS { float m, l; f32x16 o0, o1; };
DI void fs_init(FS& s) { s.m = -1e30f; s.l = 0.f; s.o0 = zero16(); s.o1 = zero16(); }

template <int DQK>
DI void load_kv(bf16x8 (&kf)[DQK / 16], s16x4 (&va)[2][4], const bf16_t* __restrict__ Kp, int ldk, const bf16_t* __restrict__ Vt, int ldv, int kt, int r, int h) {
  const int key0 = kt * 32;
  const bf16_t* kp = Kp + (size_t)(key0 + r) * ldk + 8 * h;
#pragma unroll
  for (int ks = 0; ks < DQK / 16; ++ks) kf[ks] = *(const bf16x8*)(kp + 16 * ks);
  const bf16_t* v0p = Vt + (size_t)r * ldv + key0 + 4 * h;
  const bf16_t* v1p = v0p + (size_t)32 * ldv;
#pragma unroll
  for (int q4 = 0; q4 < 4; ++q4) { va[0][q4] = *(const s16x4*)(v0p + 8 * q4); va[1][q4] = *(const s16x4*)(v1p + 8 * q4); }
}

DI void make_cs2(f32x2 (&cs2)[8], float slope2, int kmul) {
#pragma unroll
  for (int j = 0; j < 8; ++j) {
    const int i0 = 2 * j, i1 = 2 * j + 1;
    cs2[j] = (f32x2){slope2 * (float)(kmul * ((i0 & 3) + 8 * (i0 >> 2))), slope2 * (float)(kmul * ((i1 & 3) + 8 * (i1 >> 2)))};
  }
}

struct PendPV { bf16x8 p0, p1, v00, v01, v10, v11; bool on; };
DI void pv_flush(FS& st, PendPV& pd) {
  if (pd.on) {
    st.o0 = MFMA(pd.v00, pd.p0, st.o0); st.o0 = MFMA(pd.v01, pd.p1, st.o0);
    st.o1 = MFMA(pd.v10, pd.p0, st.o1); st.o1 = MFMA(pd.v11, pd.p1, st.o1);
    pd.on = false;
  }
}

template <int DQK, int KMUL>
DI void flash_tile_math(FS& st, const bf16x8* qf, const bf16x8 (&kf)[DQK / 16], const s16x4 (&va)[2][4], int kt, int q0, int qpos, int kadd, unsigned window,
                        float scale2, float slope2, const f32x2 (&cs2)[8], unsigned selmask, bool use_sel, int h, PendPV& pd) {
  const int key0 = kt * 32;
  f32x16 s = zero16();
#pragma unroll
  for (int ks = 0; ks < DQK / 16; ++ks) s = MFMA(kf[ks], qf[ks], s);
  pv_flush(st, pd);
  const int dbase = qpos - kadd - KMUL * (key0 + 4 * h);
  const float zb = -slope2 * (float)dbase;
  const bool lsel = use_sel ? (((selmask >> (kt >> 1)) & 1u) != 0u) : true;
  bool need_mask = (KMUL != 1) || (key0 + 31 > q0) || ((unsigned)(q0 + 31 - key0) >= window);
  if (use_sel) need_mask = need_mask || (__ballot(lsel) != ~0ull);
  bf16x8 p0, p1;
  if (need_mask) {
    float z[16];
    float tmax = -1e30f;
#pragma unroll
    for (int i = 0; i < 16; ++i) {
      const int c = (i & 3) + 8 * (i >> 2);
      const int dist = dbase - KMUL * c;
      const bool ok = ((unsigned)dist < window) && lsel;
      float zi = fmaf(s[i], scale2, zb + slope2 * (float)(KMUL * c));
      zi = ok ? zi : -1e30f;
      z[i] = zi; tmax = fmaxf(tmax, zi);
    }
    tmax = fmaxf(tmax, __shfl_xor(tmax, 32));
    const float mn = fmaxf(st.m, tmax);
    const float alpha = ex2(st.m - mn);
    st.m = mn;
    float pv[16]; float ps = 0.f;
#pragma unroll
    for (int i = 0; i < 16; ++i) { float pi = ex2(z[i] - mn); pi = (z[i] > -1e29f) ? pi : 0.f; pv[i] = pi; ps += pi; }
    st.l = st.l * alpha + ps;
    st.o0 *= alpha; st.o1 *= alpha;
    p0 = pack8(pv[0], pv[1], pv[2], pv[3], pv[4], pv[5], pv[6], pv[7]);
    p1 = pack8(pv[8], pv[9], pv[10], pv[11], pv[12], pv[13], pv[14], pv[15]);
  } else {
    f32x2 u2[8];
    float tmax = -3e38f;
#pragma unroll
    for (int j = 0; j < 8; ++j) {
      const f32x2 sv = {s[2 * j], s[2 * j + 1]};
      u2[j] = sv * scale2 + cs2[j];
      tmax = fmaxf(fmaxf(u2[j][0], u2[j][1]), tmax);
    }
    tmax += zb;
    tmax = fmaxf(tmax, __shfl_xor(tmax, 32));
    if (__ballot(tmax > st.m) != 0ull) {
      const float mn = fmaxf(st.m, tmax);
      const float alpha = ex2(st.m - mn);
      st.m = mn; st.l *= alpha; st.o0 *= alpha; st.o1 *= alpha;
    }
    const float d = st.m - zb;
    f32x2 ps2 = {0.f, 0.f};
    unsigned pk[8];
#pragma unroll
    for (int j = 0; j < 8; ++j) {
      const f32x2 e = u2[j] - d;
      const f32x2 pp = {ex2(e[0]), ex2(e[1])};
      ps2 += pp;
      pk[j] = pk2(pp[0], pp[1]);
    }
    st.l += ps2[0] + ps2[1];
    p0 = __builtin_bit_cast(bf16x8, (u32x4){pk[0], pk[1], pk[2], pk[3]});
    p1 = __builtin_bit_cast(bf16x8, (u32x4){pk[4], pk[5], pk[6], pk[7]});
  }
  pd.p0 = p0; pd.p1 = p1;
  pd.v00 = cat8(va[0][0], va[0][1]); pd.v01 = cat8(va[0][2], va[0][3]); pd.v10 = cat8(va[1][0], va[1][1]); pd.v11 = cat8(va[1][2], va[1][3]);
  pd.on = true;
}

template <int DQK, int KMUL>
DI void flash_direct(FS& st, const bf16x8* qf, const bf16_t* __restrict__ Kp, int ldk, const bf16_t* __restrict__ Vt, int ldv, int kt_lo, int kt_hi,
                     int q0, int qpos, int kadd, unsigned window, float scale2, float slope2, int r, int h) {
  f32x2 cs2[8];
  make_cs2(cs2, slope2, KMUL);
  PendPV pd; pd.on = false;
  for (int kt = kt_hi; kt >= kt_lo; --kt) {
    bf16x8 kf[DQK / 16]; s16x4 va[2][4];
    load_kv<DQK>(kf, va, Kp, ldk, Vt, ldv, kt, r, h);
    flash_tile_math<DQK, KMUL>(st, qf, kf, va, kt, q0, qpos, kadd, window, scale2, slope2, cs2, 0u, false, h, pd);
  }
  pv_flush(st, pd);
}

template <int DQK, int NKV> struct StageCfg {
  static constexpr int KCH = 32 * DQK / 8, CS = KCH + 256, NCH = NKV * CS / 512, KST = DQK * 2 + 16, SS = 32 * KST + 64 * 80, BUFSZ = NKV * SS;
};
template <int DQK, int NKV, int NCHX>
DI void stage_load(u32x4 (&reg)[NCHX], const bf16_t* __restrict__ K, int ldk, int kstr, const bf16_t* __restrict__ V, int ldv, int vstr, int kt, int tid) {
  typedef StageCfg<DQK, NKV> C;
#pragma unroll
  for (int i = 0; i < C::NCH; ++i) {
    const int c = tid + 512 * i, sx = c / C::CS, wi = c % C::CS;
    const bf16_t* g;
    if (wi < C::KCH) { const int row = wi / (DQK / 8), ch = wi % (DQK / 8); g = K + (size_t)sx * kstr + (size_t)(kt * 32 + row) * ldk + ch * 8; }
    else { const int w2 = wi - C::KCH, row = w2 >> 2, ch = w2 & 3; g = V + (size_t)sx * vstr + (size_t)row * ldv + kt * 32 + ch * 8; }
    reg[i] = *(const u32x4*)g;
  }
}
template <int DQK, int NKV, int NCHX>
DI void stage_store(const u32x4 (&reg)[NCHX], char* buf, int tid) {
  typedef StageCfg<DQK, NKV> C;
#pragma unroll
  for (int i = 0; i < C::NCH; ++i) {
    const int c = tid + 512 * i, sx = c / C::CS, wi = c % C::CS;
    int off;
    if (wi < C::KCH) { const int row = wi / (DQK / 8), ch = wi % (DQK / 8); off = row * C::KST + ch * 16; }
    else { const int w2 = wi - C::KCH, row = w2 >> 2, ch = w2 & 3; off = 32 * C::KST + row * 80 + ch * 16; }
    *(u32x4*)(buf + sx * C::SS + off) = reg[i];
  }
}
template <int DQK>
DI void lds_kv(bf16x8 (&kf)[DQK / 16], s16x4 (&va)[2][4], const char* sb, int r, int h) {
  constexpr int KST = DQK * 2 + 16;
#pragma unroll
  for (int ks = 0; ks < DQK / 16; ++ks) kf[ks] = *(const bf16x8*)(sb + r * KST + (16 * ks + 8 * h) * 2);
  const char* vb = sb + 32 * KST + r * 80 + 8 * h;
#pragma unroll
  for (int q4 = 0; q4 < 4; ++q4) { va[0][q4] = *(const s16x4*)(vb + 16 * q4); va[1][q4] = *(const s16x4*)(vb + 32 * 80 + 16 * q4); }
}

DI unsigned wave_or32(unsigned v) {
  unsigned u = 0u;
  for (int j = 0; j < 32; ++j) if (__ballot(((v >> j) & 1u) != 0u) != 0ull) u |= 1u << j;
  return u;
}

template <int DQK, int NKV>
DI void flash_block(FS& st, const bf16x8* qf, int sidx, const bf16_t* __restrict__ K, int ldk, int kstr, const bf16_t* __restrict__ V, int ldv, int vstr,
                    int blk_lo, int blk_hi, int my_lo, int my_hi, int q0, int qpos, unsigned window, float scale2, float slope2,
                    unsigned selmask, bool use_sel, char* tbuf, unsigned* bum, int tid, int r, int h) {
  typedef StageCfg<DQK, NKV> C;
  unsigned umask = 0xffffffffu, bmask = 0xffffffffu;
  if (use_sel) {
    umask = wave_or32(selmask);
    if (tid == 0) *bum = 0u;
    __syncthreads();
    if ((tid & 63) == 0) atomicOr(bum, umask);
    __syncthreads();
    bmask = *bum;
  }
  f32x2 cs2[8];
  make_cs2(cs2, slope2, 1);
  PendPV pd; pd.on = false;
  int kt = blk_hi;
  if (use_sel) while (kt >= blk_lo && !((bmask >> (kt >> 1)) & 1u)) --kt;
  if (kt < blk_lo) return;
  int kt1 = kt - 1;
  if (use_sel) while (kt1 >= blk_lo && !((bmask >> (kt1 >> 1)) & 1u)) --kt1;
  u32x4 rg0[C::NCH], rg1[C::NCH];
  stage_load<DQK, NKV>(rg0, K, ldk, kstr, V, ldv, vstr, kt, tid);
  stage_load<DQK, NKV>(rg1, K, ldk, kstr, V, ldv, vstr, kt1 > blk_lo ? kt1 : blk_lo, tid);
  stage_store<DQK, NKV>(rg0, tbuf, tid);
  __syncthreads();
#define FB_ROUND(RA, RB, BUFC, BUFN) { \
    int kt2 = kt1 - 1; \
    if (use_sel) while (kt2 >= blk_lo && !((bmask >> (kt2 >> 1)) & 1u)) --kt2; \
    stage_load<DQK, NKV>(RA, K, ldk, kstr, V, ldv, vstr, kt2 > blk_lo ? kt2 : blk_lo, tid);     \
    if (kt >= my_lo && kt <= my_hi && ((umask >> (kt >> 1)) & 1u)) { \
      bf16x8 kf[DQK / 16]; s16x4 va[2][4]; \
      lds_kv<DQK>(kf, va, tbuf + (BUFC) * C::BUFSZ + sidx * C::SS, r, h); \
      flash_tile_math<DQK, 1>(st, qf, kf, va, kt, q0, qpos, 0, window, scale2, slope2, cs2, selmask, use_sel, h, pd); \
    } \
    if (kt1 >= blk_lo) stage_store<DQK, NKV>(RB, tbuf + (BUFN) * C::BUFSZ, tid); \
    asm volatile("s_waitcnt lgkmcnt(0)" ::: "memory"); __builtin_amdgcn_s_barrier(); asm volatile("" ::: "memory");   \
    kt = kt1; kt1 = kt2; }
  for (;;) {
    FB_ROUND(rg0, rg1, 0, 1);
    if (kt < blk_lo) break;
    FB_ROUND(rg1, rg0, 1, 0);
    if (kt < blk_lo) break;
  }
#undef FB_ROUND
  pv_flush(st, pd);
}

DI void sb_tile_math(f32x16& o0, f32x16& o1, float& R, const bf16x8* qf, const bf16x8 (&kf)[4], const s16x4 (&va)[2][4], int kt, int qpos, int h) {
  const int key0 = kt * 32;
  f32x16 s = zero16();
#pragma unroll
  for (int ks = 0; ks < 4; ++ks) s = MFMA(kf[ks], qf[ks], s);
  const int kb = key0 + 4 * h;
  float beta[16], om[16];
#pragma unroll
  for (int i = 0; i < 16; ++i) {
    const int c = (i & 3) + 8 * (i >> 2);
    const float zz = s[i] * 0.125f;
    const float e = ex2(-fabsf(zz) * LOG2E);
    const float rr = __builtin_amdgcn_rcpf(1.f + e);
    const float sm = e * rr;
    const bool pos = zz >= 0.f, ok = (kb + c) < qpos;
    beta[i] = ok ? (pos ? rr : sm) : 0.f;
    om[i] = ok ? (pos ? sm : rr) : 1.f;
  }
  float G[4], Go[4], T[4];
#pragma unroll
  for (int g = 0; g < 4; ++g) { G[g] = (om[4 * g] * om[4 * g + 1]) * (om[4 * g + 2] * om[4 * g + 3]); Go[g] = __shfl_xor(G[g], 32); T[g] = G[g] * Go[g]; }
  float after[4];
  after[3] = 1.f; after[2] = T[3]; after[1] = T[3] * T[2]; after[0] = after[1] * T[1];
  const float total = after[0] * T[0];
  float a[16];
#pragma unroll
  for (int g = 0; g < 4; ++g) {
    const float ag = (h == 0 ? Go[g] : 1.f) * after[g] * R;
    float t = ag;
    a[4 * g + 3] = beta[4 * g + 3] * t; t *= om[4 * g + 3];
    a[4 * g + 2] = beta[4 * g + 2] * t; t *= om[4 * g + 2];
    a[4 * g + 1] = beta[4 * g + 1] * t; t *= om[4 * g + 1];
    a[4 * g] = beta[4 * g] * t;
  }
  R *= total;
  const bf16x8 p0 = pack8(a[0], a[1], a[2], a[3], a[4], a[5], a[6], a[7]);
  const bf16x8 p1 = pack8(a[8], a[9], a[10], a[11], a[12], a[13], a[14], a[15]);
  o0 = MFMA(cat8(va[0][0], va[0][1]), p0, o0); o0 = MFMA(cat8(va[0][2], va[0][3]), p1, o0);
  o1 = MFMA(cat8(va[1][0], va[1][1]), p0, o1); o1 = MFMA(cat8(va[1][2], va[1][3]), p1, o1);
}

DI void sb_block(f32x16& o0, f32x16& o1, const bf16x8* qf, int sidx, const bf16_t* __restrict__ K, int ldk, int kstr, const bf16_t* __restrict__ V, int ldv, int vstr,
                 int blk_hi, int my_hi, int qpos, char* tbuf, int tid, int r, int h) {
  typedef StageCfg<64, 4> C;
  float R = 1.f;
  bool alive = true;
  u32x4 reg[C::NCH];
  int kt = blk_hi;
  stage_load<64, 4>(reg, K, ldk, kstr, V, ldv, vstr, kt, tid);
  stage_store<64, 4>(reg, tbuf, tid);
  __syncthreads();
  int it = 0;
  for (;;) {
    const bool more = kt > 0;
    if (more) stage_load<64, 4>(reg, K, ldk, kstr, V, ldv, vstr, kt - 1, tid);
    if (alive && kt <= my_hi) {
      bf16x8 kf[4]; s16x4 va[2][4];
      lds_kv<64>(kf, va, tbuf + (it & 1) * C::BUFSZ + sidx * C::SS, r, h);
      sb_tile_math(o0, o1, R, qf, kf, va, kt, qpos, h);
      alive = __ballot(R != 0.f) != 0ull;
    }
    if (more) stage_store<64, 4>(reg, tbuf + ((it + 1) & 1) * C::BUFSZ, tid);
    const int any = __syncthreads_or(alive ? 1 : 0);
    if (!more || !any) break;
    --kt; ++it;
  }
  __syncthreads();
}

DI float sigmoidf_(float x) { return 1.f / (1.f + __expf(-x)); }
DI void acc_store(float* accl, const f32x16& a, const f32x16& b, float f) {
#pragma unroll
  for (int i = 0; i < 16; ++i) { accl[i * 512] = a[i] * f; accl[(16 + i) * 512] = b[i] * f; }
}
DI void acc_add(float* accl, const f32x16& a, const f32x16& b, float f) {
#pragma unroll
  for (int i = 0; i < 16; ++i) { accl[i * 512] += a[i] * f; accl[(16 + i) * 512] += b[i] * f; }
}
DI void acc_final(const float* accl, f32x16& o0, f32x16& o1, const f32x16& a, const f32x16& b, float f) {
#pragma unroll
  for (int i = 0; i < 16; ++i) { o0[i] = accl[i * 512] + a[i] * f; o1[i] = accl[(16 + i) * 512] + b[i] * f; }
}

DI void attn_unit(const Params& p, int l, int b, int qtp, int grp, char* smem) {
  const int tid = my_tid(), lane = tid & 63, w = (tid >> 6) & 3, half = tid >> 8, r = lane & 31, h = lane >> 5;
  const int qt = qtp * 2 + half;
  const bf16_t* QK = (const bf16_t*)(p.ws + OFF_QK);
  const bf16_t* VT = (const bf16_t*)(p.ws + OFF_VT) + (size_t)b * VROWS * SEQ;
  const size_t tok0 = (size_t)b * SEQ;
  const int q0 = qt * 32, qpos = q0 + r;
  const bf16_t* qrow = QK + (tok0 + qpos) * QKW + 8 * h;
  const bf16_t* Kb = QK + tok0 * QKW;
  float* imp = (float*)(smem + half * 16896);
  unsigned* selm = (unsigned*)(smem + 33792 + half * 128);
  float* gn = (float*)(smem + 34048 + half * 512);
  float* accl = (float*)(smem + 35328) + tid;
  unsigned* bum = (unsigned*)(smem + 35076);
  char* tbuf = smem + (grp == 2 ? 35328 : 100864);
  const int q0b = qtp * 64, qtb = qtp * 2 + 1;
  const unsigned INFW = 0x7fffffffu;
  f32x16 o0 = zero16(), o1 = zero16();
  bf16x8 qf[4];
  bool group_norm = true;

  if (grp == 0) {
    const float lam_init = 0.8f - 0.6f * __expf(-0.3f * (float)l);
    float d1 = 0.f, d2 = 0.f;
    for (int i = 0; i < 32; ++i) { d1 += p.lq1[l * 32 + i] * p.lk1[l * 32 + i]; d2 += p.lq2[l * 32 + i] * p.lk2[l * 32 + i]; }
    const float lam = __expf(d1) - __expf(d2) + lam_init;
    const float slope2 = ex2(-(2.f / 3.f) * (float)(3 * w + 2)) * LOG2E;
    const float scale2 = 0.17677669529663687f * LOG2E;
#pragma unroll 1
    for (int c = 0; c < 2; ++c) {
      qf[0] = *(const bf16x8*)(qrow + 1024 + w * 64 + c * 32);
      qf[1] = *(const bf16x8*)(qrow + 1024 + w * 64 + c * 32 + 16);
      FS st; fs_init(st);
      flash_block<32, 4>(st, qf, w, Kb + 1280 + c * 32, QKW, 64, VT + (size_t)384 * SEQ, SEQ, 64 * SEQ, 0, qtb, 0, qt, q0, qpos, INFW, scale2, slope2, 0u, false, tbuf, bum, tid, r, h);
      const float lt = st.l + __shfl_xor(st.l, 32);
      if (c == 0) acc_store(accl, st.o0, st.o1, 1.f / lt);
      else acc_add(accl, st.o0, st.o1, -lam / lt);
    }
#pragma unroll
    for (int i = 0; i < 16; ++i) { o0[i] = accl[i * 512]; o1[i] = accl[(16 + i) * 512]; }
    float ss = 0.f;
#pragma unroll
    for (int i = 0; i < 16; ++i) ss += o0[i] * o0[i] + o1[i] * o1[i];
    ss += __shfl_xor(ss, 32);
    const float sc = rsqrtf(ss * (1.f / 64.f) + EPS) * (1.f - lam_init);
    o0 *= sc; o1 *= sc;
    group_norm = false;
  } else if (grp == 1) {
#pragma unroll
    for (int ks = 0; ks < 4; ++ks) qf[ks] = *(const bf16x8*)(qrow + 512 + w * 64 + 16 * ks);
    const float slope2 = ex2(-(2.f / 3.f) * (float)(3 * w + 1)) * LOG2E;
    const float scale2 = 0.125f * LOG2E;
    const float* gp = (const float*)(p.ws + OFF_GATE) + (tok0 + qpos) * 16 + w * 3;
    const float g0 = sigmoidf_(gp[0]), g1 = sigmoidf_(gp[1]), g2 = sigmoidf_(gp[2]);
    const bf16_t* kc = (const bf16_t*)(p.ws + OFF_KCMP) + (size_t)b * 128 * 64;
    const bf16_t* vc = (const bf16_t*)(p.ws + OFF_VCMP) + (size_t)b * 64 * 128;
    const int ktc = min(3, qt >> 4);
    {
      FS st; fs_init(st);
      flash_direct<64, 16>(st, qf, kc, 64, vc, 128, 0, ktc, q0, qpos, 31, INFW, scale2, slope2, r, h);
      const float lt = st.l + __shfl_xor(st.l, 32);
      const float inv = lt > 0.f ? 1.f / lt : 0.f;
      acc_store(accl, st.o0, st.o1, inv * g0);
      float* impw = imp + (w * 32 + r) * 33;
      for (int kt = 0; kt < 4; ++kt) {
        if (kt <= ktc) {
          const int key0 = kt * 32;
          const bf16_t* kp = kc + (size_t)(key0 + r) * 64 + 8 * h;
          f32x16 s = zero16();
#pragma unroll
          for (int ks = 0; ks < 4; ++ks) s = MFMA(*(const bf16x8*)(kp + 16 * ks), qf[ks], s);
          const int dbase = qpos - 31 - 16 * (key0 + 4 * h);
          const float zb = -slope2 * (float)dbase;
#pragma unroll
          for (int g = 0; g < 4; ++g) {
            float sum4 = 0.f;
#pragma unroll
            for (int k = 0; k < 4; ++k) {
              const int c = k + 8 * g;
              const int dist = dbase - 16 * c;
              const float zi = fmaf(s[4 * g + k], scale2, zb + slope2 * (float)(16 * c));
              const float pi = (dist >= 0) ? ex2(zi - st.m) * inv : 0.f;
              sum4 += pi;
            }
            impw[8 * kt + 2 * g + h] = sum4;
          }
        } else {
#pragma unroll
          for (int g = 0; g < 4; ++g) impw[8 * kt + 2 * g + h] = 0.f;
        }
      }
    }
    __syncthreads();
    if ((tid & 255) < 32) {
      const int cur = qt >> 1;
      const float* scp = imp + (tid & 255) * 33;
      float sc[32];
#pragma unroll
      for (int j = 0; j < 32; ++j) {
        const float v = scp[j] + scp[j + 32 * 33] + scp[j + 2 * 32 * 33] + scp[j + 3 * 32 * 33];
        const bool forced = (j == 0) || (j == cur) || (j == cur - 1);
        sc[j] = (j > cur) ? -1e30f : (forced ? 1e9f : v);
      }
      unsigned mask = 0u;
#pragma unroll 1
      for (int n = 0; n < 8; ++n) {
        float best = -INFINITY; int bj = 0;
#pragma unroll
        for (int j = 0; j < 32; ++j) { const bool gt = sc[j] > best; best = gt ? sc[j] : best; bj = gt ? j : bj; }
#pragma unroll
        for (int j = 0; j < 32; ++j) sc[j] = (j == bj) ? -INFINITY : sc[j];
        mask |= 1u << bj;
      }
      selm[tid & 255] = mask;
    }
    __syncthreads();
    const unsigned selmask = selm[r];
    {
      FS st; fs_init(st);
      flash_block<64, 1>(st, qf, 0, Kb + 896, QKW, 0, VT + (size_t)256 * SEQ, SEQ, 0, 0, qtb, 0, qt, q0, qpos, INFW, scale2, slope2, selmask, true, tbuf, bum, tid, r, h);
      const float lt = st.l + __shfl_xor(st.l, 32);
      acc_add(accl, st.o0, st.o1, g1 / lt);
    }
    {
      FS st; fs_init(st);
      const int lo = q0 >= 511 ? ((q0 - 511) >> 5) : 0, lob = q0b >= 511 ? ((q0b - 511) >> 5) : 0;
      flash_block<64, 1>(st, qf, 0, Kb + 960, QKW, 0, VT + (size_t)320 * SEQ, SEQ, 0, lob, qtb, lo, qt, q0, qpos, 512u, scale2, slope2, 0u, false, tbuf, bum, tid, r, h);
      const float lt = st.l + __shfl_xor(st.l, 32);
      acc_final(accl, o0, o1, st.o0, st.o1, g2 / lt);
    }
  } else if (grp == 2) {
#pragma unroll
    for (int ks = 0; ks < 4; ++ks) qf[ks] = *(const bf16x8*)(qrow + w * 64 + 16 * ks);
    sb_block(o0, o1, qf, w, Kb + 256, QKW, 64, VT, SEQ, 64 * SEQ, qtb, qt, qpos, tbuf, tid, r, h);
  } else {
#pragma unroll
    for (int ks = 0; ks < 4; ++ks) qf[ks] = *(const bf16x8*)(qrow + 1536 + w * 64 + 16 * ks);
    const float slope2 = ex2(-(2.f / 3.f) * (float)(3 * w + 3)) * LOG2E;
    const float scale2 = 0.125f * LOG2E;
    FS st; fs_init(st);
    const int lo = q0 >= 127 ? ((q0 - 127) >> 5) : 0, lob = q0b >= 127 ? ((q0b - 127) >> 5) : 0;
    flash_block<64, 2>(st, qf, w >> 1, Kb + 1792, QKW, 64, VT + (size_t)640 * SEQ, SEQ, 64 * SEQ, lob, qtb, lo, qt, q0, qpos, 128u, scale2, slope2, 0u, false, tbuf, bum, tid, r, h);
    float lt = st.l + __shfl_xor(st.l, 32);
    lt += ex2(p.sinks[l * 4 + w] * LOG2E - st.m);
    const float f = 1.f / lt;
    o0 = st.o0 * f; o1 = st.o1 * f;
  }

  if (group_norm) {
    float ss = 0.f;
#pragma unroll
    for (int i = 0; i < 16; ++i) ss += o0[i] * o0[i] + o1[i] * o1[i];
    ss += __shfl_xor(ss, 32);
    if (h == 0) gn[w * 32 + r] = ss;
    __syncthreads();
    const float tot = gn[r] + gn[32 + r] + gn[64 + r] + gn[96 + r];
    const float sc = rsqrtf(tot * (1.f / 256.f) + EPS);
    o0 *= sc; o1 *= sc;
  }
  const int gcol = (grp == 2 ? 0 : grp == 1 ? 256 : grp == 0 ? 512 : 768) + w * 64 + 4 * h;
  bf16_t* mrow = (bf16_t*)(p.ws + OFF_MIX) + (tok0 + qpos) * DM + gcol;
#pragma unroll
  for (int g = 0; g < 4; ++g) {
    u32x2 a = {pk2(o0[4 * g], o0[4 * g + 1]), pk2(o0[4 * g + 2], o0[4 * g + 3])};
    u32x2 c = {pk2(o1[4 * g], o1[4 * g + 1]), pk2(o1[4 * g + 2], o1[4 * g + 3])};
    *(u32x2*)(mrow + 8 * g) = a;
    *(u32x2*)(mrow + 32 + 8 * g) = c;
  }
  __syncthreads();
}

DI void phase_attn(const Params& p, int l, char* smem) {
  int* ctr = (int*)(p.ws + OFF_CTR) + l * 8;
  int* su = (int*)(smem + 35072);
  const int xcd = blockIdx.x & 7;
  int k = 0;
  for (;;) {
    if (my_tid() == 0) {
      int U = -1;
      for (; k < 8; ++k) {
        const int x = (xcd + k) & 7;
        const int v = atomicAdd(ctr + x, 1);
        if (v < 512) { U = x * 512 + v; break; }
      }
      *su = U;
    }
    __syncthreads();
    const int U = *su;
    __syncthreads();
    if (U < 0) break;
    const int x = U >> 9, v = U & 511;
    const int b = x * 4 + 3 - (v >> 7), wq = v & 127;
    attn_unit(p, l, b, 31 - (wq & 31), wq >> 5, smem);
  }
}

DI void phase_final(const Params& p) {
  const float* ssA = (const float*)(p.ws + OFF_SSA);
  const int lane = my_tid() & 63, gw = blockIdx.x * 8 + (my_tid() >> 6), nw = gridDim.x * 8;
  f32x4 g[4];
#pragma unroll
  for (int i = 0; i < 4; ++i) g[i] = *(const f32x4*)(p.norm_final + (i * 64 + lane) * 4);
  for (int row0 = gw; row0 < NTOK; row0 += 4 * nw) {
    u32x2 xv[4][4]; float rs[4];
#pragma unroll
    for (int q = 0; q < 4; ++q) {
      const int row = row0 + q * nw < NTOK ? row0 + q * nw : row0;
      rs[q] = row_rstd(ssA, row);
#pragma unroll
      for (int i = 0; i < 4; ++i) xv[q][i] = *(const u32x2*)((const bf16_t*)(p.ws + OFF_XB) + (size_t)row * DM + (i * 64 + lane) * 4);
    }
#pragma unroll
    for (int q = 0; q < 4; ++q) {
      const int row = row0 + q * nw;
      if (row < NTOK) {
#pragma unroll
        for (int i = 0; i < 4; ++i) *(f32x4*)(p.xw + (size_t)row * DM + (i * 64 + lane) * 4) = unpk4(xv[q][i]) * rs[q] * g[i];
      }
    }
  }
}

DI void grid_bar2(unsigned* bar, unsigned epoch, unsigned per_group) {
  __syncthreads();
  if (my_tid() == 0) {
    __threadfence();
    const unsigned x = blockIdx.x & 7u;
    const unsigned prev = __hip_atomic_fetch_add(bar + x * 32, 1u, __ATOMIC_ACQ_REL, __HIP_MEMORY_SCOPE_AGENT);
    if (prev == per_group - 1u) {
      __hip_atomic_store(bar + x * 32, 0u, __ATOMIC_RELAXED, __HIP_MEMORY_SCOPE_AGENT);
      const unsigned pg = __hip_atomic_fetch_add(bar + 256, 1u, __ATOMIC_ACQ_REL, __HIP_MEMORY_SCOPE_AGENT);
      if (pg == 7u) {
        __hip_atomic_store(bar + 256, 0u, __ATOMIC_RELAXED, __HIP_MEMORY_SCOPE_AGENT);
        for (unsigned j = 0; j < 8u; ++j) __hip_atomic_store(bar + (9u + j) * 32, epoch, __ATOMIC_RELEASE, __HIP_MEMORY_SCOPE_AGENT);
      }
    }
    while (__hip_atomic_load(bar + (9u + x) * 32, __ATOMIC_RELAXED, __HIP_MEMORY_SCOPE_AGENT) < epoch) __builtin_amdgcn_s_sleep(1);
    __threadfence();
    asm volatile("s_waitcnt vmcnt(0)" ::: "memory");
  }
  __syncthreads();
}

__global__ void __launch_bounds__(512, 2) mega(Params p) {
  __shared__ __attribute__((aligned(16))) char smem[163328];
  cg::grid_group grid = cg::this_grid();
  for (int ph = p.ph_lo; ph < p.ph_hi; ++ph) {
    if (ph == 0) phase_prep(p, smem);
    else if (ph == 25) phase_final(p);
    else {
      const int l = (ph - 1) / 6, k = (ph - 1) % 6;
      if (k == 0) phase_gemm<MODE_PROJ>(p, l, smem);
      else if (k == 1) phase_cmp(p, l, smem);
      else if (k == 2) phase_attn(p, l, smem);
      else if (k == 3) phase_gemm<MODE_OUT>(p, l, smem);
      else if (k == 4) phase_gemm<MODE_UP>(p, l, smem);
      else phase_gemm<MODE_DOWN>(p, l, smem);
    }
    if (ph + 1 < p.ph_hi) {
      if (ph == p.ph_lo || (gridDim.x & 7u) != 0u) grid.sync();
      else grid_bar2((unsigned*)(p.ws + OFF_CTR + 1024), (unsigned)(ph - p.ph_lo), gridDim.x >> 3);
    }
  }
}

extern "C" void kernel_launch(void* const* d_in, const int* in_sizes, int n_in, void* d_out, int out_size, void* d_ws, size_t ws_size, hipStream_t stream) {
  static int grid_blocks = 0;
  if (!grid_blocks) {
    int dev = 0, cus = 0, per_cu = 0;
    hipGetDevice(&dev);
    hipDeviceGetAttribute(&cus, hipDeviceAttributeMultiprocessorCount, dev);
    hipOccupancyMaxActiveBlocksPerMultiprocessor(&per_cu, mega, 512, 0);
    if (per_cu > 1) per_cu = 1;
    if (per_cu < 1) per_cu = 1;
    grid_blocks = cus * per_cu;
  }
  Params p{};
  const float** f = (const float**)&p;
  for (int i = 0; i < 20; ++i) f[i] = (const float*)d_in[i];
  p.xw = (float*)d_out;
  p.ws = (char*)d_ws;
  p.ph_lo = 0; p.ph_hi = 26;
  void* args[] = {&p};
  hipError_t e = hipLaunchCooperativeKernel((void*)mega, dim3(grid_blocks), dim3(512), args, 0, stream);
  if (e != hipSuccess) fprintf(stderr, "cooperative launch failed: %s (grid %d)\n", hipGetErrorString(e), grid_blocks);
}
```
